# Optimizing an MI355X kernel written in HIP

```python
import math
import jax, jax.numpy as jnp
from jax import lax
import numpy as np

D_MODEL = 2048
BATCH = 8
SEQ = 2048
DEPTH = 2

CHUNK = 64
Q_BLOCK = 128
N_MIXERS = 2
ROPE_THETA = 500000.0
ROT_FRACTION = 4
EPS = 1e-6
BRANCH_WIDTH = D_MODEL

DIFF_HEAD_DIM = 128
DIFF_HEADS = BRANCH_WIDTH // (2 * DIFF_HEAD_DIM)
FOX_HEAD_DIM = 128
FOX_HEADS = BRANCH_WIDTH // FOX_HEAD_DIM

N_LAYERS_A = (DEPTH + 1) // 2
N_LAYERS_B = DEPTH // 2

kernel_name = "hybrid_diffattn_fox_gated_trunk"


def rms_norm(x, gain):
    xf = x.astype(jnp.float32)
    y = xf * lax.rsqrt(jnp.mean(xf * xf, axis=-1, keepdims=True) + EPS)
    return (y * gain.astype(jnp.float32)).astype(x.dtype)


def partial_rope(x, positions):
    rot = x.shape[-1] // ROT_FRACTION
    half = rot // 2
    inv_freq = ROPE_THETA ** (-jnp.arange(half, dtype=jnp.float32) / half)
    ang = positions.astype(jnp.float32)[:, :, None, None] * inv_freq
    cos, sin = jnp.cos(ang), jnp.sin(ang)
    xr = x[..., :rot].astype(jnp.float32)
    x1, x2 = xr[..., :half], xr[..., half:]
    xr = jnp.concatenate([x1 * cos - x2 * sin, x2 * cos + x1 * sin], axis=-1)
    return jnp.concatenate([xr.astype(x.dtype), x[..., rot:]], axis=-1)


def chunk_causal_diff_attention(q1, q2, k1, k2, v, lam):
    S = q1.shape[1]
    scale = q1.shape[-1] ** -0.5
    outs = []
    for start in range(0, S, Q_BLOCK):
        end = start + Q_BLOCK
        mask = (jnp.arange(end) // CHUNK)[None, :] <= (jnp.arange(start, end) // CHUNK)[:, None]

        def attn_map(q, k):
            s = jnp.einsum("bqhd,bkhd->bhqk", q[:, start:end].astype(jnp.float32),
                           k[:, :end].astype(jnp.float32)) * scale
            return jax.nn.softmax(jnp.where(mask, s, -jnp.inf), axis=-1)

        p = attn_map(q1, k1) - lam * attn_map(q2, k2)
        outs.append(jnp.einsum("bhqk,bkhe->bqhe", p.astype(v.dtype), v[:, :end]))
    return jnp.concatenate(outs, axis=1)


def forgetting_attention(q, k, v, log_f):
    S = q.shape[1]
    scale = q.shape[-1] ** -0.5
    cum = jnp.transpose(jnp.cumsum(log_f, axis=1), (0, 2, 1))
    outs = []
    for start in range(0, S, Q_BLOCK):
        end = start + Q_BLOCK
        mask = jnp.arange(end)[None, :] <= jnp.arange(start, end)[:, None]
        s = jnp.einsum("bqhd,bkhd->bhqk", q[:, start:end].astype(jnp.float32),
                       k[:, :end].astype(jnp.float32)) * scale
        s = s + (cum[:, :, start:end, None] - cum[:, :, None, :end])
        p = jax.nn.softmax(jnp.where(mask, s, -jnp.inf), axis=-1)
        outs.append(jnp.einsum("bhqk,bkhd->bqhd", p.astype(v.dtype), v[:, :end]))
    return jnp.concatenate(outs, axis=1)


def diff_attn_layer(x, positions, norm_g, w_in, q_norm_g, k_norm_g,
                    lq1, lk1, lq2, lk2, sub_norm_g, w_out, layer_idx):
    B, S, _ = x.shape
    lambda_init = 0.8 - 0.6 * math.exp(-0.3 * layer_idx)
    h = rms_norm(x, norm_g)
    q, k, v, gate = jnp.split(h @ w_in, 4, axis=-1)
    q = partial_rope(rms_norm(q.reshape(B, S, 2 * DIFF_HEADS, DIFF_HEAD_DIM), q_norm_g), positions)
    k = partial_rope(rms_norm(k.reshape(B, S, 2 * DIFF_HEADS, DIFF_HEAD_DIM), k_norm_g), positions)
    q = q.reshape(B, S, DIFF_HEADS, 2, DIFF_HEAD_DIM)
    k = k.reshape(B, S, DIFF_HEADS, 2, DIFF_HEAD_DIM)
    v = v.reshape(B, S, DIFF_HEADS, 2 * DIFF_HEAD_DIM)
    lam = (jnp.exp(jnp.sum(lq1.astype(jnp.float32) * lk1.astype(jnp.float32)))
           - jnp.exp(jnp.sum(lq2.astype(jnp.float32) * lk2.astype(jnp.float32)))
           + lambda_init)
    o = chunk_causal_diff_attention(q[:, :, :, 0], q[:, :, :, 1], k[:, :, :, 0], k[:, :, :, 1], v, lam)
    o = rms_norm(o, sub_norm_g) * (1.0 - lambda_init)
    o = o.reshape(B, S, BRANCH_WIDTH) * jax.nn.silu(gate)
    return x + o @ w_out


def forgetting_attn_layer(x, norm_g, w_in, f_bias, q_norm_g, k_norm_g, w_out):
    B, S, _ = x.shape
    h = rms_norm(x, norm_g)
    proj = h @ w_in
    q, k, v, gate = jnp.split(proj[..., :4 * BRANCH_WIDTH], 4, axis=-1)
    log_f = jax.nn.log_sigmoid(proj[..., 4 * BRANCH_WIDTH:].astype(jnp.float32)
                               + f_bias.astype(jnp.float32))
    q = rms_norm(q.reshape(B, S, FOX_HEADS, FOX_HEAD_DIM), q_norm_g)
    k = rms_norm(k.reshape(B, S, FOX_HEADS, FOX_HEAD_DIM), k_norm_g)
    v = v.reshape(B, S, FOX_HEADS, FOX_HEAD_DIM)
    o = forgetting_attention(q, k, v, log_f).reshape(B, S, BRANCH_WIDTH) * jax.nn.silu(gate)
    return x + o @ w_out


def setup_inputs(seed: int = 0) -> dict:
    key = jax.random.key(seed)
    ks = jax.random.split(key, 20)
    f32 = jnp.float32
    NA, NB = N_LAYERS_A, N_LAYERS_B

    def gain(k, shape):
        return 1.0 + 0.02 * jax.random.normal(k, shape, f32)

    x = jax.random.normal(ks[0], (BATCH, SEQ, D_MODEL), f32)
    offsets = jax.random.randint(ks[1], (BATCH, 1), 0, 64, dtype=jnp.int32) * CHUNK
    positions = (offsets + jnp.arange(SEQ, dtype=jnp.int32)[None, :]).astype(jnp.int32)
    return {
        "x": x,
        "positions": positions,
        "a_norm": gain(ks[2], (NA, D_MODEL)),
        "a_w_in": jax.random.normal(ks[3], (NA, D_MODEL, 4 * BRANCH_WIDTH), f32) * D_MODEL ** -0.5,
        "a_q_norm": gain(ks[4], (NA, DIFF_HEAD_DIM)),
        "a_k_norm": gain(ks[5], (NA, DIFF_HEAD_DIM)),
        "a_lambda_q1": 0.1 * jax.random.normal(ks[6], (NA, DIFF_HEAD_DIM), f32),
        "a_lambda_k1": 0.1 * jax.random.normal(ks[7], (NA, DIFF_HEAD_DIM), f32),
        "a_lambda_q2": 0.1 * jax.random.normal(ks[8], (NA, DIFF_HEAD_DIM), f32),
        "a_lambda_k2": 0.1 * jax.random.normal(ks[9], (NA, DIFF_HEAD_DIM), f32),
        "a_sub_norm": gain(ks[10], (NA, 2 * DIFF_HEAD_DIM)),
        "a_w_out": jax.random.normal(ks[11], (NA, BRANCH_WIDTH, D_MODEL), f32) * BRANCH_WIDTH ** -0.5,
        "b_norm": gain(ks[12], (NB, D_MODEL)),
        "b_w_in": jax.random.normal(ks[13], (NB, D_MODEL, 4 * BRANCH_WIDTH + FOX_HEADS), f32) * D_MODEL ** -0.5,
        "b_f_bias": jax.random.uniform(ks[14], (NB, FOX_HEADS), f32, minval=1.0, maxval=5.0),
        "b_q_norm": gain(ks[15], (NB, FOX_HEAD_DIM)),
        "b_k_norm": gain(ks[16], (NB, FOX_HEAD_DIM)),
        "b_w_out": jax.random.normal(ks[17], (NB, BRANCH_WIDTH, D_MODEL), f32) * BRANCH_WIDTH ** -0.5,
    }


def reference(x, positions, a_norm, a_w_in, a_q_norm, a_k_norm, a_lambda_q1, a_lambda_k1,
              a_lambda_q2, a_lambda_k2, a_sub_norm, a_w_out, b_norm, b_w_in, b_f_bias,
              b_q_norm, b_k_norm, b_w_out):
    for i in range(DEPTH):
        j = i // N_MIXERS
        if i % N_MIXERS == 0:
            x = diff_attn_layer(x, positions, a_norm[j], a_w_in[j], a_q_norm[j], a_k_norm[j],
                                a_lambda_q1[j], a_lambda_k1[j], a_lambda_q2[j], a_lambda_k2[j],
                                a_sub_norm[j], a_w_out[j], layer_idx=i)
        else:
            x = forgetting_attn_layer(x, b_norm[j], b_w_in[j], b_f_bias[j], b_q_norm[j],
                                      b_k_norm[j], b_w_out[j])
    return x
```

```cpp
#include <hip/hip_runtime.h>
#include <hip/hip_cooperative_groups.h>
#include <cstdio>
#include <cstdint>

typedef unsigned short bf16_t;
typedef short bf16x8 __attribute__((ext_vector_type(8)));
typedef float f32x4 __attribute__((ext_vector_type(4)));

constexpr int NB = 8, SEQ = 2048, DM = 2048, M = NB * SEQ;
constexpr int NQKVG = 8192, NFG = 16;
constexpr float EPS = 1e-6f;
constexpr float LAMBDA_INIT = 0.2f;
constexpr float ATT_SCALE = 0.08838834764831845f;

constexpr size_t MiB = 1u << 20;
constexpr size_t WS_MISC = 0;
constexpr size_t WS_ROPE_COS = 1 * MiB, WS_ROPE_SIN = 2 * MiB, WS_LOGF = 3 * MiB, WS_CUM = 4 * MiB;
constexpr size_t WS_W1T = 8 * MiB, WS_W2T = 40 * MiB, WS_W3T = 48 * MiB, WS_W4T = 81 * MiB;
constexpr size_t WS_XB = 96 * MiB, WS_Q = 160 * MiB, WS_K = 224 * MiB, WS_V = 288 * MiB, WS_G = 352 * MiB, WS_AO = 416 * MiB, WS_END = 480 * MiB;

__device__ __forceinline__ unsigned short f2bf(float f) { unsigned u = __float_as_uint(f); return (unsigned short)((u + 0x7fffu + ((u >> 16) & 1u)) >> 16); }
__device__ __forceinline__ float bf2f(unsigned short h) { return __uint_as_float((unsigned)h << 16); }

__device__ __forceinline__ void sincos_acc(float ang, float& c, float& s) {
    const double a = (double)ang, twopi = 6.283185307179586476925286766559;
    const double r = a - rint(a / twopi) * twopi; const double r2 = r * r;
    double ts = r, tc = 1.0, ss = r, cs = 1.0;
#pragma unroll
    for (int i = 1; i <= 14; ++i) { tc *= -r2 / (double)((2 * i - 1) * (2 * i)); ts *= -r2 / (double)((2 * i) * (2 * i + 1)); cs += tc; ss += ts; }
    c = (float)cs; s = (float)ss;
}

namespace pg8 {
#define PG8_LAS __attribute__((address_space(3)))
typedef unsigned short bf16_t;
typedef short bf16x8 __attribute__((ext_vector_type(8)));
typedef float f32x4 __attribute__((ext_vector_type(4)));
typedef unsigned u32x4 __attribute__((ext_vector_type(4)));
constexpr int BM = 256, BK = 64, HALF = 128, HTB = HALF * BK * 2  , STAGE_BYTES = 8 * HTB, NXCD = 8, WGM = 8;

__host__ __device__ __forceinline__ int lds_byte(int r, int c) { const int st = (r >> 4) * 2 + (c >> 5), rr = r & 15, cc = c & 31, ob = rr * 64 + cc * 2; return st * 1024 + (ob ^ (((ob >> 9) & 1) << 5)); }
__host__ __device__ __forceinline__ void stage_rc(int b, int& R, int& C) { const int st = b / 1024, sb = b % 1024, swz = sb ^ (((sb >> 9) & 1) << 5); R = (st >> 1) * 16 + swz / 64; C = (st & 1) * 32 + (swz % 64) / 2; }
__host__ __device__ __forceinline__ int perm32(int rho) { const int n = rho >> 4, i = rho & 15; return 8 * (i >> 2) + 4 * n + (i & 3); }

struct Unit { int pm, pn; };
struct Gemm { const bf16_t* A; const bf16_t* Bt; int M, N, K; };

struct StaticOrder {
    int nM, nN, nwg, G, c, wgm;
    __host__ __device__ void init(int M, int N, int G_, int c_, int wgm_ = WGM) { nM = M / BM; nN = N / BM; nwg = nM * nN; G = G_; c = c_; wgm = wgm_; }
    __host__ __device__ bool next(int i, Unit& u) const {
        const long L = (long)i * G + c; if (L >= nwg) return false;
        int wgid = (int)L; { const int q = nwg / NXCD, r = nwg % NXCD, xcd = wgid % NXCD, off = wgid / NXCD; wgid = (xcd < r ? xcd * (q + 1) : r * (q + 1) + (xcd - r) * q) + off; }
        const int nig = wgm * nN, gid = wgid / nig, fm = gid * wgm, gsz = (nM - fm) < wgm ? (nM - fm) : wgm;
        u.pm = fm + ((wgid % nig) % gsz); u.pn = (wgid % nig) / gsz; return true;
    }
    __device__ __forceinline__ void a_ready(const Unit&) const {}
    __device__ __forceinline__ void done(const Unit&) const {}
};


__device__ __forceinline__ unsigned cvt_pk_bf16(float lo, float hi) { unsigned r; asm volatile("v_cvt_pk_bf16_f32 %0, %1, %2" : "=v"(r) : "v"(lo), "v"(hi)); return r; }
typedef unsigned u32x2 __attribute__((ext_vector_type(2)));
#define PG8_EPI_BARRIER() do { asm volatile("s_waitcnt lgkmcnt(0)" ::: "memory"); __builtin_amdgcn_s_barrier(); asm volatile("" ::: "memory"); } while (0)
template <bool ROPE, bool PARTS> struct EpiQKVG {
    static constexpr bool PERM = true, AFTER_DRAIN = false;
    bf16_t* Q; bf16_t* K; bf16_t* V; bf16_t* G;
    const float* rstd;
    const float* qg; const float* kg; const float* rcos; const float* rsin;
    PG8_LAS float* P;
    __device__ __forceinline__ void operator()(f32x4 (&acc)[2][2][4][2], const Unit& u, int wr, int wc, int fr, int fq) const {
        const int sec = u.pn >> 3, hc = (u.pn & 7) * 256, rl0 = wr * 64 + fr;
#pragma unroll
        for (int ai = 0; ai < 2; ++ai)
#pragma unroll
            for (int m = 0; m < 4; ++m) { if (PARTS) { const int row = u.pm * BM + ai * HALF + rl0 + m * 16;
                const f32x4 a = *(const f32x4*)(rstd + (size_t)row * 8), b = *(const f32x4*)(rstd + (size_t)row * 8 + 4);
                const float rs = __builtin_amdgcn_rsqf(((a[0] + a[1]) + (a[2] + a[3]) + (b[0] + b[1]) + (b[2] + b[3])) * (1.0f / 2048.f) + 1e-6f);
#pragma unroll
                for (int bj = 0; bj < 2; ++bj)
#pragma unroll
                    for (int n = 0; n < 2; ++n) acc[ai][bj][m][n] = acc[ai][bj][m][n] * rs; } }
        if (sec <= 1) {
#pragma unroll
            for (int ai = 0; ai < 2; ++ai)
#pragma unroll
                for (int m = 0; m < 4; ++m) { const int rloc = ai * HALF + rl0 + m * 16;
#pragma unroll
                    for (int bj = 0; bj < 2; ++bj) { const f32x4 a = acc[ai][bj][m][0], b = acc[ai][bj][m][1];
                        float ss = (a[0] * a[0] + a[1] * a[1]) + (a[2] * a[2] + a[3] * a[3]) + (b[0] * b[0] + b[1] * b[1]) + (b[2] * b[2] + b[3] * b[3]);
                        ss += __shfl_xor(ss, 16); ss += __shfl_xor(ss, 32);
                        if (fq == 0) P[rloc * 8 + bj * 4 + wc] = ss; } }
            PG8_EPI_BARRIER();
            const float* gn = (sec == 0 ? qg : kg) + wc * 32 + 8 * fq;
            const f32x4 g0 = *(const f32x4*)gn, g1 = *(const f32x4*)(gn + 4);
            bf16_t* dst = sec == 0 ? Q : K;
#pragma unroll
            for (int ai = 0; ai < 2; ++ai)
#pragma unroll
                for (int m = 0; m < 4; ++m) { const int rloc = ai * HALF + rl0 + m * 16, row = u.pm * BM + rloc;
                    f32x4 c0, c1, s0, s1;
                    if (ROPE && wc == 0) { const float* cp = rcos + (size_t)row * 16 + 8 * (fq & 1); const float* sp = rsin + (size_t)row * 16 + 8 * (fq & 1);
                        c0 = *(const f32x4*)cp; c1 = *(const f32x4*)(cp + 4); s0 = *(const f32x4*)sp; s1 = *(const f32x4*)(sp + 4);
                        if (fq < 2) { s0 = -s0; s1 = -s1; } }
#pragma unroll
                    for (int bj = 0; bj < 2; ++bj) { const f32x4 p4 = *(const PG8_LAS f32x4*)(P + rloc * 8 + bj * 4);
                        const float rh = __builtin_amdgcn_rsqf(((p4[0] + p4[1]) + (p4[2] + p4[3])) * (1.0f / 128.f) + 1e-6f);
                        f32x4 v0 = acc[ai][bj][m][0] * rh * g0, v1 = acc[ai][bj][m][1] * rh * g1;
                        if (ROPE && wc == 0) {
#pragma unroll
                            for (int j = 0; j < 4; ++j) { const float p0 = __shfl_xor(v0[j], 32), p1 = __shfl_xor(v1[j], 32);
                                v0[j] = v0[j] * c0[j] + p0 * s0[j]; v1[j] = v1[j] * c1[j] + p1 * s1[j]; } }
                        u32x4 w; w.x = cvt_pk_bf16(v0[0], v0[1]); w.y = cvt_pk_bf16(v0[2], v0[3]); w.z = cvt_pk_bf16(v1[0], v1[1]); w.w = cvt_pk_bf16(v1[2], v1[3]);
                        *(u32x4*)(dst + (size_t)row * 2048 + hc + bj * HALF + wc * 32 + 8 * fq) = w; } }
        } else {
            bf16_t* dst = sec == 2 ? V : G;
#pragma unroll
            for (int ai = 0; ai < 2; ++ai)
#pragma unroll
                for (int m = 0; m < 4; ++m) { const int row = u.pm * BM + ai * HALF + rl0 + m * 16;
#pragma unroll
                    for (int bj = 0; bj < 2; ++bj) { f32x4 v0 = acc[ai][bj][m][0], v1 = acc[ai][bj][m][1];
                        if (sec == 3) {
#pragma unroll
                            for (int j = 0; j < 4; ++j) { v0[j] = v0[j] * __builtin_amdgcn_rcpf(1.0f + __builtin_amdgcn_exp2f(-1.4426950408889634f * v0[j]));
                                                          v1[j] = v1[j] * __builtin_amdgcn_rcpf(1.0f + __builtin_amdgcn_exp2f(-1.4426950408889634f * v1[j])); } }
                        u32x4 w; w.x = cvt_pk_bf16(v0[0], v0[1]); w.y = cvt_pk_bf16(v0[2], v0[3]); w.z = cvt_pk_bf16(v1[0], v1[1]); w.w = cvt_pk_bf16(v1[2], v1[3]);
                        *(u32x4*)(dst + (size_t)row * 2048 + hc + bj * HALF + wc * 32 + 8 * fq) = w; } }
        }
    }
};

struct EpiNull { static constexpr bool PERM = true, AFTER_DRAIN = false;
    __device__ __forceinline__ void operator()(f32x4 (&acc)[2][2][4][2], const Unit&, int, int, int, int) const {
#pragma unroll
        for (int ai = 0; ai < 2; ++ai)
#pragma unroll
            for (int bj = 0; bj < 2; ++bj)
#pragma unroll
                for (int m = 0; m < 4; ++m)
#pragma unroll
                    for (int n = 0; n < 2; ++n) asm volatile("" :: "v"(acc[ai][bj][m][n])); } };
struct EpiResMid {
    static constexpr bool PERM = false, AFTER_DRAIN = false;
    const float* resid; bf16_t* xb; float* ssqp; PG8_LAS float* P;
    __device__ __forceinline__ void operator()(f32x4 (&acc)[2][2][4][2], const Unit& u, int wr, int wc, int fr, int fq) const {
        const int col0 = u.pn * BM + wc * 32 + 4 * fq, rl0 = wr * 64 + fr;
#pragma unroll
        for (int ai = 0; ai < 2; ++ai)
#pragma unroll
            for (int m = 0; m < 4; ++m) { const int rloc = ai * HALF + rl0 + m * 16; const size_t off = (size_t)(u.pm * BM + rloc) * 2048 + col0; float ss = 0.f;
#pragma unroll
                for (int bj = 0; bj < 2; ++bj)
#pragma unroll
                    for (int n = 0; n < 2; ++n) { const f32x4 r = *(const f32x4*)(resid + off + bj * HALF + n * 16); const f32x4 o = r + acc[ai][bj][m][n];
                        ss += (o[0] * o[0] + o[1] * o[1]) + (o[2] * o[2] + o[3] * o[3]);
                        u32x2 w; w.x = cvt_pk_bf16(o[0], o[1]); w.y = cvt_pk_bf16(o[2], o[3]); *(u32x2*)(xb + off + bj * HALF + n * 16) = w; }
                ss += __shfl_xor(ss, 16); ss += __shfl_xor(ss, 32); if (fq == 0) P[rloc * 4 + wc] = ss;
                if (m & 1) asm volatile("" ::: "memory"); }
        PG8_EPI_BARRIER();
        if (wc == 0 && fq == 0) {
#pragma unroll
            for (int ai = 0; ai < 2; ++ai)
#pragma unroll
                for (int m = 0; m < 4; ++m) { const int rloc = ai * HALF + rl0 + m * 16; const f32x4 p4 = *(const PG8_LAS f32x4*)(P + rloc * 4);
                    ssqp[(size_t)(u.pm * BM + rloc) * 8 + u.pn] = (p4[0] + p4[1]) + (p4[2] + p4[3]); } }
    }
};
struct EpiResOut {
    static constexpr bool PERM = false, AFTER_DRAIN = false;
    const bf16_t* xb; float* out;
    __device__ __forceinline__ void operator()(f32x4 (&acc)[2][2][4][2], const Unit& u, int wr, int wc, int fr, int fq) const {
        const int col0 = u.pn * BM + wc * 32 + 4 * fq, rl0 = wr * 64 + fr;
#pragma unroll
        for (int ai = 0; ai < 2; ++ai)
#pragma unroll
            for (int m = 0; m < 4; ++m) { const size_t off = (size_t)(u.pm * BM + ai * HALF + rl0 + m * 16) * 2048 + col0;
#pragma unroll
                for (int bj = 0; bj < 2; ++bj)
#pragma unroll
                    for (int n = 0; n < 2; ++n) { const u32x2 r = *(const u32x2*)(xb + off + bj * HALF + n * 16);
                        f32x4 o = acc[ai][bj][m][n]; o[0] += __uint_as_float(r.x << 16); o[1] += __uint_as_float(r.x & 0xffff0000u); o[2] += __uint_as_float(r.y << 16); o[3] += __uint_as_float(r.y & 0xffff0000u);
                        *(f32x4*)(out + off + bj * HALF + n * 16) = o; }
                if (m & 1) asm volatile("" ::: "memory"); }
    }
};

template <class Epi, class Sched, bool ALIGN_EPI = false, bool SP2 = false>
__device__ __forceinline__ void gemm_phase(PG8_LAS unsigned char* lds, const Gemm g, const Sched& S, const Epi& E, const int tid) {
    const int wid = __builtin_amdgcn_readfirstlane(tid >> 6), lane = tid & 63, wr = wid >> 2, wc = wid & 3, fr = lane & 15, fq = lane >> 4;
    const int K = g.K, nt = K / BK;
    unsigned voffA[2], voffB[2];
#pragma unroll
    for (int i = 0; i < 2; ++i) { int R, C; stage_rc(tid * 16 + i * 8192, R, C); const int Rb = Epi::PERM ? ((R & ~31) + perm32(R & 31)) : R;
        voffA[i] = (unsigned)(R * K + C) * 2u; voffB[i] = (unsigned)(Rb * K + C) * 2u; }
    const size_t kstep = (size_t)(BK * 2);
    const size_t hstep = (size_t)HALF * K * 2;
    const size_t tstep = 2 * hstep;
    const unsigned ldsw = (unsigned)wid * 1024u;
    const int aoff = lds_byte(wr * 64 + fr, fq * 8), boff = lds_byte(wc * 32 + fr, fq * 8);
#define PG8_SA(b, h) (((b) * 2 + (h)) * HTB)
#define PG8_SB(b, h) ((4 + (b) * 2 + (h)) * HTB)
#define PG8_STAGE(bufoff, gbase, voff) do { _Pragma("unroll") for (int _i = 0; _i < 2; ++_i) \
        __builtin_amdgcn_global_load_lds((const unsigned*)((const char*)(gbase) + (voff)[_i]), (PG8_LAS unsigned*)(lds + (bufoff) + ldsw + _i * 8192), 16, 0, 0); } while (0)
#define PG8_LDA(dst, b, h) do { _Pragma("unroll") for (int m = 0; m < 4; ++m) _Pragma("unroll") for (int k = 0; k < 2; ++k) dst[m][k] = *(const PG8_LAS bf16x8*)(lds + PG8_SA(b, h) + aoff + m * 2048 + k * 1024); } while (0)
#define PG8_LDB(dst, b, h) do { _Pragma("unroll") for (int n = 0; n < 2; ++n) _Pragma("unroll") for (int k = 0; k < 2; ++k) dst[n][k] = *(const PG8_LAS bf16x8*)(lds + PG8_SB(b, h) + boff + n * 2048 + k * 1024); } while (0)
#define PG8_MMA(ai, bj, At, Bt) do { __builtin_amdgcn_s_setprio(1); _Pragma("unroll") for (int m = 0; m < 4; ++m) _Pragma("unroll") for (int n = 0; n < 2; ++n) _Pragma("unroll") for (int k = 0; k < 2; ++k) \
        acc[ai][bj][m][n] = __builtin_amdgcn_mfma_f32_16x16x32_bf16(Bt[n][k], At[m][k], acc[ai][bj][m][n], 0, 0, 0); __builtin_amdgcn_s_setprio(0); } while (0)
#define PG8_WAIT_V(n) asm volatile("s_waitcnt vmcnt(" #n ")" ::: "memory")
#define PG8_WAIT_L(n) asm volatile("s_waitcnt lgkmcnt(" #n ")" ::: "memory")
#define PG8_BAR __builtin_amdgcn_s_barrier()
#define PG8_SCHED __builtin_amdgcn_sched_barrier(0)
    Unit cur, nxt; int ui = 0;
    if (!S.next(0, cur)) return;
    f32x4 acc[2][2][4][2];
#pragma unroll
    for (int a = 0; a < 2; ++a)
#pragma unroll
        for (int b = 0; b < 2; ++b)
#pragma unroll
            for (int m = 0; m < 4; ++m)
#pragma unroll
                for (int n = 0; n < 2; ++n) acc[a][b][m][n] = (f32x4){0.f, 0.f, 0.f, 0.f};
    bf16x8 At[4][2], B0[2][2], B1[2][2];
    const char* cA = (const char*)g.A + (size_t)cur.pm * tstep; const char* cB = (const char*)g.Bt + (size_t)cur.pn * tstep;
    S.a_ready(cur);
    if constexpr (SP2) {
        PG8_STAGE(PG8_SB(0, 0), cB, voffB); PG8_STAGE(PG8_SB(0, 1), cB + hstep, voffB); PG8_STAGE(PG8_SA(0, 0), cA, voffA); PG8_STAGE(PG8_SA(0, 1), cA + hstep, voffA);
        if (wr == 1) PG8_BAR;
        PG8_WAIT_V(2); PG8_BAR;
        PG8_STAGE(PG8_SB(1, 0), cB + kstep, voffB); PG8_STAGE(PG8_SA(1, 0), cA + kstep, voffA); PG8_STAGE(PG8_SB(1, 1), cB + hstep + kstep, voffB);
        PG8_WAIT_V(6); PG8_BAR;
    } else {
        PG8_STAGE(PG8_SB(0, 0), cB, voffB); PG8_STAGE(PG8_SA(0, 0), cA, voffA); PG8_STAGE(PG8_SB(0, 1), cB + hstep, voffB); PG8_STAGE(PG8_SA(0, 1), cA + hstep, voffA);
        if (wr == 1) PG8_BAR;
        PG8_WAIT_V(4); PG8_BAR;
        PG8_STAGE(PG8_SB(1, 0), cB + kstep, voffB); PG8_STAGE(PG8_SA(1, 0), cA + kstep, voffA); PG8_STAGE(PG8_SB(1, 1), cB + hstep + kstep, voffB);
        PG8_WAIT_V(6); PG8_BAR;
    }
    for (;;) {
        const bool has_next = S.next(ui + 1, nxt);
        const char* nA = has_next ? (const char*)g.A + (size_t)nxt.pm * tstep : cA; const char* nB = has_next ? (const char*)g.Bt + (size_t)nxt.pn * tstep : cB;
        for (int t = 0; t < nt; t += 2) {
            const bool last = (t == nt - 2);
            const char* a1 = cA + (size_t)(t + 1) * kstep;
            const char* a2 = last ? nA : cA + (size_t)(t + 2) * kstep; const char* b2 = last ? nB : cB + (size_t)(t + 2) * kstep;
            const char* a3 = a2 + kstep; const char* b3 = b2 + kstep;
            if (last && has_next) S.a_ready(nxt);
            if constexpr (SP2) {
            PG8_LDB(B0, 0, 0); PG8_LDB(B1, 0, 1); PG8_SCHED; PG8_LDA(At, 0, 0); PG8_STAGE(PG8_SA(1, 1), a1 + hstep, voffA);
            PG8_WAIT_V(8); PG8_WAIT_L(0); PG8_BAR; PG8_MMA(0, 0, At, B0); PG8_MMA(0, 1, At, B1); PG8_BAR; PG8_SCHED;
            PG8_LDA(At, 0, 1); PG8_STAGE(PG8_SB(0, 0), b2, voffB); PG8_STAGE(PG8_SB(0, 1), b2 + hstep, voffB); PG8_STAGE(PG8_SA(0, 0), a2, voffA);
            PG8_WAIT_V(8); PG8_WAIT_L(0); PG8_BAR; PG8_MMA(1, 0, At, B0); PG8_MMA(1, 1, At, B1); PG8_BAR; PG8_SCHED;
            PG8_LDB(B0, 1, 0); PG8_LDB(B1, 1, 1); PG8_SCHED; PG8_LDA(At, 1, 0); PG8_STAGE(PG8_SA(0, 1), a2 + hstep, voffA);
            PG8_WAIT_V(8); PG8_WAIT_L(0); PG8_BAR; PG8_MMA(0, 0, At, B0); PG8_MMA(0, 1, At, B1); PG8_BAR; PG8_SCHED;
            PG8_LDA(At, 1, 1); PG8_STAGE(PG8_SB(1, 0), b3, voffB); PG8_STAGE(PG8_SB(1, 1), b3 + hstep, voffB); PG8_STAGE(PG8_SA(1, 0), a3, voffA);
            PG8_WAIT_V(8); PG8_WAIT_L(0); PG8_BAR; PG8_MMA(1, 0, At, B0); PG8_MMA(1, 1, At, B1); PG8_BAR; PG8_SCHED;
            } else {
            PG8_LDB(B0, 0, 0); PG8_SCHED; PG8_LDA(At, 0, 0); PG8_STAGE(PG8_SA(1, 1), a1 + hstep, voffA);
            PG8_WAIT_L(8); PG8_BAR; PG8_WAIT_L(0); PG8_MMA(0, 0, At, B0); PG8_BAR; PG8_SCHED;
            PG8_LDB(B1, 0, 1); PG8_STAGE(PG8_SB(0, 0), b2, voffB);
            PG8_BAR; PG8_WAIT_L(0); PG8_MMA(0, 1, At, B1); PG8_BAR;
            PG8_LDA(At, 0, 1); PG8_STAGE(PG8_SA(0, 0), a2, voffA);
            PG8_BAR; PG8_WAIT_L(0); PG8_MMA(1, 0, At, B0); PG8_BAR; PG8_SCHED;
            PG8_STAGE(PG8_SB(0, 1), b2 + hstep, voffB);
            PG8_WAIT_V(6); PG8_BAR; PG8_MMA(1, 1, At, B1); PG8_BAR;
            PG8_LDB(B0, 1, 0); PG8_SCHED; PG8_LDA(At, 1, 0); PG8_STAGE(PG8_SA(0, 1), a2 + hstep, voffA);
            PG8_WAIT_L(8); PG8_BAR; PG8_WAIT_L(0); PG8_MMA(0, 0, At, B0); PG8_BAR; PG8_SCHED;
            PG8_LDB(B1, 1, 1); PG8_STAGE(PG8_SB(1, 0), b3, voffB);
            PG8_BAR; PG8_WAIT_L(0); PG8_MMA(0, 1, At, B1); PG8_BAR;
            PG8_LDA(At, 1, 1); PG8_STAGE(PG8_SA(1, 0), a3, voffA);
            PG8_BAR; PG8_WAIT_L(0); PG8_MMA(1, 0, At, B0); PG8_BAR; PG8_SCHED;
            PG8_STAGE(PG8_SB(1, 1), b3 + hstep, voffB);
            PG8_WAIT_V(6); PG8_BAR; PG8_MMA(1, 1, At, B1); PG8_BAR;
            }
        }
        if constexpr (ALIGN_EPI) { if (wr == 0) PG8_BAR; }
        if constexpr (!Epi::AFTER_DRAIN) { E(acc, cur, wr, wc, fr, fq); S.done(cur); }
        if (!has_next) break;
#pragma unroll
        for (int a = 0; a < 2; ++a)
#pragma unroll
            for (int b = 0; b < 2; ++b)
#pragma unroll
                for (int m = 0; m < 4; ++m)
#pragma unroll
                    for (int n = 0; n < 2; ++n) acc[a][b][m][n] = (f32x4){0.f, 0.f, 0.f, 0.f};
        cur = nxt; cA = nA; cB = nB; ++ui;
        if constexpr (ALIGN_EPI) { if (wr == 1) PG8_BAR; }
    }
    PG8_WAIT_V(0);
    if constexpr (!ALIGN_EPI) { if (wr == 0) PG8_BAR; }
    PG8_BAR;
    if constexpr (Epi::AFTER_DRAIN) { E.fused(acc, cur, wr, wc, fr, fq, lds, wid, lane); S.done(cur); }
#undef PG8_SA
#undef PG8_SB
#undef PG8_STAGE
#undef PG8_LDA
#undef PG8_LDB
#undef PG8_MMA
#undef PG8_WAIT_V
#undef PG8_WAIT_L
#undef PG8_BAR
#undef PG8_SCHED
}
}

namespace cg = cooperative_groups;
#ifndef WGM_BIG
#define WGM_BIG 4
#endif
#ifndef WGM_SMALL
#define WGM_SMALL 4
#endif
static_assert(8 % WGM_BIG == 0 && 8 % WGM_SMALL == 0, "the group barriers need every batch's 8 row tiles inside one XCD-chunk of the GEMM tile order: the group size must divide 8");
#ifndef PG8_SP2
#define PG8_SP2 true
#endif
#define LAS __attribute__((address_space(3)))
constexpr int NWAVES = 8, NTHREADS = NWAVES * 64;
constexpr int RING_BYTES = 131072;
constexpr int EPI_OFF = RING_BYTES;
constexpr int LDS_BYTES = 147456;
constexpr size_t WS_SSQP = 5 * MiB;

__device__ __forceinline__ int lane_id_v() { int l; asm volatile("v_mbcnt_lo_u32_b32 %0, -1, 0\n\tv_mbcnt_hi_u32_b32 %0, -1, %0" : "=v"(l)); return l; }
__device__ __forceinline__ int make_tid(const int wave_s) { return wave_s * 64 + lane_id_v(); }
namespace att {
typedef short s16x4 __attribute__((ext_vector_type(4)));
typedef float f32x16 __attribute__((ext_vector_type(16)));
typedef unsigned u32x4 __attribute__((ext_vector_type(4)));
constexpr int D = 128, PITCH = 2048, NW = 8, QBLK = 32, KVBLK = 64, QB = NW * QBLK;
constexpr int SHM_V = KVBLK * D * 2, SHM_K = KVBLK * D * 2;
constexpr int OFF_WS = 2 * SHM_V + 2 * SHM_K;
constexpr int OFF_BIAS = OFF_WS + NW * 64 * 4;
constexpr int OFF_SSQ = OFF_BIAS + 2048 * 4;
constexpr int OFF_STG = OFF_SSQ + NW * 32 * 4 + 256;
constexpr int LDS_END = OFF_STG + NW * 8192;
static_assert(OFF_STG % 16 == 0 && LDS_END <= LDS_BYTES, "attention LDS map");
constexpr float SCALE = 0.08838834764831845f, THR = 8.f;
#define KSWZ(row, colB) ((row) * 256 + ((colB) ^ (((row) & 15) << 4)))
#define SBAR() __builtin_amdgcn_sched_barrier(0)
__device__ __forceinline__ int v_st(int k, int c) { const int kk = (k & ~0xC) | ((k & 4) << 1) | ((k & 8) >> 1); return ((kk >> 3) * 4 + (c >> 5)) * 512 + ((kk & 7) * 32 + (c & 31)) * 2; }
__device__ __forceinline__ int v_rd_base(int lane) { return ((lane & 3) << 3) | (((lane >> 2) & 3) << 6) | (((lane >> 4) & 1) << 5) | (((lane >> 5) & 1) << 8); }
constexpr int v_rd_off(int d0, int ks, int half) { return d0 * 512 + ks * 4096 + half * 2048; }
__device__ __forceinline__ int crow(int r, int hi) { return (r & 3) + 8 * (r >> 2) + 4 * hi; }
__device__ __forceinline__ unsigned cvtpk(float lo, float hi) { unsigned r; asm volatile("v_cvt_pk_bf16_f32 %0, %1, %2" : "=v"(r) : "v"(lo), "v"(hi)); return r; }
__device__ __forceinline__ void mask_tile(f32x16& p0, f32x16& p1, int dq) {
    const float NEG = -__builtin_inff();
#pragma unroll
    for (int r = 0; r < 16; ++r) { const int c = (r & 3) + 8 * (r >> 2); if (dq - c < 0) p0[r] = NEG; if (dq - c - 32 < 0) p1[r] = NEG; }
}
__device__ __forceinline__ void partialSM(f32x16& p0, f32x16& p1, float& m_reg, float& mn, float& alpha) {
    float pmax = p0[0]; for (int r = 1; r < 16; ++r) pmax = fmaxf(pmax, p0[r]); for (int r = 0; r < 16; ++r) pmax = fmaxf(pmax, p1[r]);
    { auto rr = __builtin_amdgcn_permlane32_swap(__float_as_uint(pmax), __float_as_uint(pmax), false, false);
      pmax = fmaxf(__uint_as_float(rr[0]), __uint_as_float(rr[1])); }
    constexpr float C2 = 1.4426950408889634f * SCALE;
    if (__builtin_expect(__all((pmax - m_reg) * SCALE <= THR), 1)) { mn = m_reg; alpha = 1.f; }
    else { mn = fmaxf(m_reg, pmax); alpha = __builtin_amdgcn_exp2f((m_reg - mn) * C2); m_reg = mn; }
    const float mnL = -mn * C2;
    for (int r = 0; r < 16; ++r) p0[r] = fmaf(p0[r], C2, mnL); for (int r = 0; r < 16; ++r) p1[r] = fmaf(p1[r], C2, mnL);
    for (int r = 0; r < 16; ++r) p0[r] = __builtin_amdgcn_exp2f(p0[r]);
}
__device__ __forceinline__ void finishSM(f32x16& p0, f32x16& p1, float alpha, float& l_reg, bf16x8& pa0, bf16x8& pa1, bf16x8& pa2, bf16x8& pa3) {
    for (int r = 0; r < 16; ++r) p1[r] = __builtin_amdgcn_exp2f(p1[r]);
    float ps = 0; for (int r = 0; r < 16; ++r) ps += p0[r]; for (int r = 0; r < 16; ++r) ps += p1[r];
    { auto rr = __builtin_amdgcn_permlane32_swap(__float_as_uint(ps), __float_as_uint(ps), false, false);
      ps = __uint_as_float(rr[0]) + __uint_as_float(rr[1]); }
    l_reg = l_reg * alpha + ps;
#define PK4(P, B_, OUT) do { unsigned a0 = cvtpk(P[B_+0], P[B_+1]), a1 = cvtpk(P[B_+2], P[B_+3]);                          \
        unsigned b0 = cvtpk(P[B_+4], P[B_+5]), b1 = cvtpk(P[B_+6], P[B_+7]);                                             \
        auto r0 = __builtin_amdgcn_permlane32_swap(a0, b0, false, false); auto r1 = __builtin_amdgcn_permlane32_swap(a1, b1, false, false); \
        u32x4 w = {r0[0], r1[0], r0[1], r1[1]}; OUT = *reinterpret_cast<bf16x8*>(&w); } while (0)
    PK4(p0, 0, pa0); PK4(p0, 8, pa1); PK4(p1, 0, pa2); PK4(p1, 8, pa3);
#undef PK4
}
template <int KB, bool BIAS, bool NOLDS = false>
__device__ __forceinline__ void qkt(f32x16& p0, f32x16& p1, const char* K_lds, int r32, int hi, const bf16x8* qr, const float* bptr) {
    if constexpr (BIAS) {
#pragma unroll
        for (int g = 0; g < 4; ++g) { const f32x4 a = *(const f32x4*)(bptr + 8 * g), b = *(const f32x4*)(bptr + 32 + 8 * g);
            p0[4 * g] = a[0]; p0[4 * g + 1] = a[1]; p0[4 * g + 2] = a[2]; p0[4 * g + 3] = a[3]; p1[4 * g] = b[0]; p1[4 * g + 1] = b[1]; p1[4 * g + 2] = b[2]; p1[4 * g + 3] = b[3]; }
    } else { p0 = f32x16{}; p1 = f32x16{}; }
#pragma unroll
    for (int d0 = 0; d0 < 8; ++d0) { const char* a = K_lds + KB * SHM_K + KSWZ(r32, (d0 * 16 + hi * 8) * 2);
        bf16x8 b0, b1;
        if constexpr (NOLDS) { b0 = qr[(d0 + 1) & 7]; b1 = qr[(d0 + 2) & 7]; } else { b0 = *reinterpret_cast<const bf16x8*>(a); b1 = *reinterpret_cast<const bf16x8*>(a + 32 * 256); }
        p0 = __builtin_amdgcn_mfma_f32_32x32x16_bf16(b0, qr[d0], p0, 0, 0, 0);
        p1 = __builtin_amdgcn_mfma_f32_32x32x16_bf16(b1, qr[d0], p1, 0, 0, 0); }
}
template <int VB, bool NOLDS = false>
__device__ __forceinline__ void pv_tile(f32x16* o, int vb0, bf16x8 pa0, bf16x8 pa1, bf16x8 pa2, bf16x8 pa3) {
    if constexpr (NOLDS) {
#pragma unroll
        for (int d0 = 0; d0 < 4; ++d0) { o[d0] = __builtin_amdgcn_mfma_f32_32x32x16_bf16(pa0, pa1, o[d0], 0, 0, 0); o[d0] = __builtin_amdgcn_mfma_f32_32x32x16_bf16(pa1, pa2, o[d0], 0, 0, 0);
            o[d0] = __builtin_amdgcn_mfma_f32_32x32x16_bf16(pa2, pa3, o[d0], 0, 0, 0); o[d0] = __builtin_amdgcn_mfma_f32_32x32x16_bf16(pa3, pa0, o[d0], 0, 0, 0); }
        return; }
#define TRRD(dst, off) asm volatile("ds_read_b64_tr_b16 %0, %1 offset:%2" : "=&v"(dst) : "v"(vb0), "i"(off) : "memory")
#define PV_D0(d0) do { s16x4 l0, l1, l2, l3, h0, h1, h2, h3; constexpr int b_ = VB * SHM_V + v_rd_off(d0, 0, 0); \
        TRRD(l0, b_); TRRD(h0, b_ + 2048); TRRD(l1, b_ + 4096); TRRD(h1, b_ + 6144); TRRD(l2, b_ + 8192); TRRD(h2, b_ + 10240); TRRD(l3, b_ + 12288); TRRD(h3, b_ + 14336); \
        asm volatile("s_waitcnt lgkmcnt(0)" ::: "memory"); SBAR();   \
        o[d0] = __builtin_amdgcn_mfma_f32_32x32x16_bf16(pa0, (bf16x8){l0[0], l0[1], l0[2], l0[3], h0[0], h0[1], h0[2], h0[3]}, o[d0], 0, 0, 0);   \
        o[d0] = __builtin_amdgcn_mfma_f32_32x32x16_bf16(pa1, (bf16x8){l1[0], l1[1], l1[2], l1[3], h1[0], h1[1], h1[2], h1[3]}, o[d0], 0, 0, 0);   \
        o[d0] = __builtin_amdgcn_mfma_f32_32x32x16_bf16(pa2, (bf16x8){l2[0], l2[1], l2[2], l2[3], h2[0], h2[1], h2[2], h2[3]}, o[d0], 0, 0, 0);   \
        o[d0] = __builtin_amdgcn_mfma_f32_32x32x16_bf16(pa3, (bf16x8){l3[0], l3[1], l3[2], l3[3], h3[0], h3[1], h3[2], h3[3]}, o[d0], 0, 0, 0); } while (0)
    PV_D0(0); PV_D0(1); PV_D0(2); PV_D0(3);
#undef PV_D0
#undef TRRD
}
template <int VB>
__device__ __forceinline__ void pv_sm(f32x16* o, int vb0, bf16x8 pa0, bf16x8 pa1, bf16x8 pa2, bf16x8 pa3, f32x16& x0, f32x16& x1, float& m_reg, float& mn, float& alpha) {
    constexpr float C2 = 1.4426950408889634f * SCALE;
    float pmax, mnL;
#define TRRD(dst, off) asm volatile("ds_read_b64_tr_b16 %0, %1 offset:%2" : "=&v"(dst) : "v"(vb0), "i"(off) : "memory")
#define PV_RD(d0) s16x4 l0, l1, l2, l3, h0, h1, h2, h3; { constexpr int b_ = VB * SHM_V + v_rd_off(d0, 0, 0); \
        TRRD(l0, b_); TRRD(h0, b_ + 2048); TRRD(l1, b_ + 4096); TRRD(h1, b_ + 6144); TRRD(l2, b_ + 8192); TRRD(h2, b_ + 10240); TRRD(l3, b_ + 12288); TRRD(h3, b_ + 14336); } SBAR()
#define PV_MM(d0) SBAR(); asm volatile("s_waitcnt lgkmcnt(0)" ::: "memory"); SBAR();   \
        o[d0] = __builtin_amdgcn_mfma_f32_32x32x16_bf16(pa0, (bf16x8){l0[0], l0[1], l0[2], l0[3], h0[0], h0[1], h0[2], h0[3]}, o[d0], 0, 0, 0);   \
        o[d0] = __builtin_amdgcn_mfma_f32_32x32x16_bf16(pa1, (bf16x8){l1[0], l1[1], l1[2], l1[3], h1[0], h1[1], h1[2], h1[3]}, o[d0], 0, 0, 0);   \
        o[d0] = __builtin_amdgcn_mfma_f32_32x32x16_bf16(pa2, (bf16x8){l2[0], l2[1], l2[2], l2[3], h2[0], h2[1], h2[2], h2[3]}, o[d0], 0, 0, 0);   \
        o[d0] = __builtin_amdgcn_mfma_f32_32x32x16_bf16(pa3, (bf16x8){l3[0], l3[1], l3[2], l3[3], h3[0], h3[1], h3[2], h3[3]}, o[d0], 0, 0, 0)
    { PV_RD(0);
      pmax = x0[0]; for (int r = 1; r < 16; ++r) pmax = fmaxf(pmax, x0[r]);
      PV_MM(0); }
    { PV_RD(1);
      for (int r = 0; r < 16; ++r) pmax = fmaxf(pmax, x1[r]);
      { auto rr = __builtin_amdgcn_permlane32_swap(__float_as_uint(pmax), __float_as_uint(pmax), false, false); pmax = fmaxf(__uint_as_float(rr[0]), __uint_as_float(rr[1])); }
      const bool keep = __all((pmax - m_reg) * SCALE <= THR);
      mn = keep ? m_reg : fmaxf(m_reg, pmax); alpha = keep ? 1.f : __builtin_amdgcn_exp2f((m_reg - mn) * C2); m_reg = mn; mnL = -mn * C2;
      PV_MM(1); }
    { PV_RD(2);
      for (int r = 0; r < 16; ++r) x0[r] = fmaf(x0[r], C2, mnL); for (int r = 0; r < 16; ++r) x1[r] = fmaf(x1[r], C2, mnL);
      PV_MM(2); }
    { PV_RD(3);
      for (int r = 0; r < 16; ++r) x0[r] = __builtin_amdgcn_exp2f(x0[r]);
      PV_MM(3); }
#undef PV_RD
#undef PV_MM
#undef TRRD
}
__device__ __forceinline__ void psm_fix(f32x16& p0, f32x16& p1, float mnL) {
    constexpr float C2 = 1.4426950408889634f * SCALE;
    for (int r = 0; r < 16; ++r) p0[r] = fmaf(p0[r], C2, mnL); for (int r = 0; r < 16; ++r) p1[r] = fmaf(p1[r], C2, mnL);
    for (int r = 0; r < 16; ++r) p0[r] = __builtin_amdgcn_exp2f(p0[r]);
}
__device__ __forceinline__ void fsm_fix(f32x16& p0, f32x16& p1, bf16x8& pa0, bf16x8& pa1, bf16x8& pa2, bf16x8& pa3) {
    for (int r = 0; r < 16; ++r) p1[r] = __builtin_amdgcn_exp2f(p1[r]);
#define PK4(P, B_, OUT) do { unsigned a0 = cvtpk(P[B_+0], P[B_+1]), a1 = cvtpk(P[B_+2], P[B_+3]);                          \
        unsigned b0 = cvtpk(P[B_+4], P[B_+5]), b1 = cvtpk(P[B_+6], P[B_+7]);                                             \
        auto r0 = __builtin_amdgcn_permlane32_swap(a0, b0, false, false); auto r1 = __builtin_amdgcn_permlane32_swap(a1, b1, false, false); \
        u32x4 w = {r0[0], r1[0], r0[1], r1[1]}; OUT = *reinterpret_cast<bf16x8*>(&w); } while (0)
    PK4(p0, 0, pa0); PK4(p0, 8, pa1); PK4(p1, 0, pa2); PK4(p1, 8, pa3);
#undef PK4
}
template <int VB>
__device__ __forceinline__ void pv_smf(f32x16* o, int vb0, bf16x8 pa0, bf16x8 pa1, bf16x8 pa2, bf16x8 pa3, f32x16& x0, f32x16& x1, float mnL) {
    constexpr float C2 = 1.4426950408889634f * SCALE;
#define TRRD(dst, off) asm volatile("ds_read_b64_tr_b16 %0, %1 offset:%2" : "=&v"(dst) : "v"(vb0), "i"(off) : "memory")
#define PV_RD(d0) s16x4 l0, l1, l2, l3, h0, h1, h2, h3; { constexpr int b_ = VB * SHM_V + v_rd_off(d0, 0, 0); \
        TRRD(l0, b_); TRRD(h0, b_ + 2048); TRRD(l1, b_ + 4096); TRRD(h1, b_ + 6144); TRRD(l2, b_ + 8192); TRRD(h2, b_ + 10240); TRRD(l3, b_ + 12288); TRRD(h3, b_ + 14336); } SBAR()
#define PV_MM(d0) SBAR(); asm volatile("s_waitcnt lgkmcnt(0)" ::: "memory"); SBAR();   \
        o[d0] = __builtin_amdgcn_mfma_f32_32x32x16_bf16(pa0, (bf16x8){l0[0], l0[1], l0[2], l0[3], h0[0], h0[1], h0[2], h0[3]}, o[d0], 0, 0, 0);   \
        o[d0] = __builtin_amdgcn_mfma_f32_32x32x16_bf16(pa1, (bf16x8){l1[0], l1[1], l1[2], l1[3], h1[0], h1[1], h1[2], h1[3]}, o[d0], 0, 0, 0);   \
        o[d0] = __builtin_amdgcn_mfma_f32_32x32x16_bf16(pa2, (bf16x8){l2[0], l2[1], l2[2], l2[3], h2[0], h2[1], h2[2], h2[3]}, o[d0], 0, 0, 0);   \
        o[d0] = __builtin_amdgcn_mfma_f32_32x32x16_bf16(pa3, (bf16x8){l3[0], l3[1], l3[2], l3[3], h3[0], h3[1], h3[2], h3[3]}, o[d0], 0, 0, 0)
    { PV_RD(0); for (int r = 0; r < 16; ++r) x0[r] = fmaf(x0[r], C2, mnL); PV_MM(0); }
    { PV_RD(1); for (int r = 0; r < 16; ++r) x1[r] = fmaf(x1[r], C2, mnL); PV_MM(1); }
    { PV_RD(2); for (int r = 0; r < 8; ++r) x0[r] = __builtin_amdgcn_exp2f(x0[r]); PV_MM(2); }
    { PV_RD(3); for (int r = 8; r < 16; ++r) x0[r] = __builtin_amdgcn_exp2f(x0[r]); PV_MM(3); }
#undef PV_RD
#undef PV_MM
#undef TRRD
}
struct BlockRef { const bf16_t* Q; const bf16_t* K; const bf16_t* V; int P0; int row0; int head; int step; int jlo; };
struct Seam { bf16x8 qr[8]; bf16x8 st_v0, st_v1, st_k0, st_k1; };
#define ROW(p, k0, rr) ((p) + (size_t)((k0) + (rr)) * PITCH + sc)
#define VMW() asm volatile("s_waitcnt vmcnt(0)" ::: "memory")
#define VMWN(n) asm volatile("s_waitcnt vmcnt(%0)" :: "i"(n) : "memory")
#define SLOAD_H(Kp, Vp, k0) do { S.st_v0 = *(const bf16x8*)ROW(Vp, k0, sr); S.st_v1 = *(const bf16x8*)ROW(Vp, k0, 32 + sr);              \
                         S.st_k0 = *(const bf16x8*)ROW(Kp, k0, sr); S.st_k1 = *(const bf16x8*)ROW(Kp, k0, 32 + sr); } while (0)
#define SWRITE_HK(bf) do { *(bf16x8*)(K_lds + (bf) * SHM_K + kws) = S.st_k0; *(bf16x8*)(K_lds + (bf) * SHM_K + kws + 32 * 256) = S.st_k1; } while (0)
#define SWRITE_HV(bf) do { *(bf16x8*)(V_lds + (bf) * SHM_V + vst0) = S.st_v0; *(bf16x8*)(V_lds + (bf) * SHM_V + vst1) = S.st_v1; } while (0)
#define SWRITE_H(bf) do { SWRITE_HV(bf); SWRITE_HK(bf); } while (0)
template <int MODE>
__device__ __forceinline__ void attn_prime(const BlockRef& cur, char* lds, Seam& S, const int wave_s) {
    const int tid = make_tid(wave_s); const int wid = __builtin_amdgcn_readfirstlane(tid >> 6), lane = tid & 63, r32 = lane & 31, hi = lane >> 5;
    const int sr = tid >> 4, sc = (tid & 15) * 8, kws = KSWZ(sr, sc * 2); char* K_lds = lds + 2 * SHM_V;
    for (int d0 = 0; d0 < 8; ++d0) S.qr[d0] = *(const bf16x8*)(cur.Q + (size_t)(wid * QBLK + r32) * PITCH + d0 * 16 + hi * 8);
    SLOAD_H(cur.K, cur.V, (MODE == 1 ? cur.P0 + 3 * KVBLK : 0)); VMW(); SWRITE_HK(0);
    __syncthreads();
}
template <int MODE, class Epi, bool FIXM = false>
__device__ __forceinline__ void attn_block(const BlockRef& cur, const BlockRef& nxt, char* lds, Seam& S, const Epi& epi, const int wave_s) {
    constexpr bool BIAS = MODE == 1;
    const int tid = make_tid(wave_s); const int wid = __builtin_amdgcn_readfirstlane(tid >> 6), lane = tid & 63, r32 = lane & 31, hi = lane >> 5;
    const int NTF = cur.P0 / KVBLK + 4, NT = NTF - (MODE == 1 ? cur.jlo : 0);
    const int qlo = cur.P0 + wid * QBLK;
    const int qlimw = MODE == 0 ? (qlo | 63) : qlo;
    const int qm = (MODE == 0 ? (qlo | 63) : qlo + r32) - 4 * hi;
    char* V_lds = lds; char* K_lds = lds + 2 * SHM_V;
    float* ws = (float*)(lds + OFF_WS) + wid * 64; float* li_l = ws, * al_l = ws + 32;
    const float* btab = (const float*)(lds + OFF_BIAS) + 4 * hi;
    float m_reg = -1e30f, l_reg = 0; f32x16 o[4] = {};
    float2* stat = (float2*)(lds + OFF_BIAS) + (wid * 2 + (cur.step & 1)) * 32;
    float mnLf = 0.f, mA_ = 0.f, alA_ = 1.f; (void)mnLf; (void)mA_; (void)alA_;
    if constexpr (FIXM) { const float2 ml = stat[r32]; m_reg = ml.x; l_reg = ml.y; mnLf = -ml.x * (1.4426950408889634f * SCALE); }
    const int sr = tid >> 4, sc = (tid & 15) * 8, vst0 = v_st(sr, sc), vst1 = v_st(32 + sr, sc), kws = KSWZ(sr, sc * 2);
    const int vb0 = (int)(uintptr_t)V_lds + v_rd_base(lane);
    const bf16_t* Kh = cur.K; const bf16_t* Vh = cur.V;
#define RESC(a) do { if constexpr (!FIXM) if (__any((a) < 1.f)) { if (hi == 0) al_l[r32] = (a); asm volatile("s_waitcnt lgkmcnt(0)" ::: "memory");              \
                     for (int d_ = 0; d_ < 4; ++d_) for (int r = 0; r < 16; ++r) o[d_][r] *= al_l[crow(r, hi)]; } } while (0)
#define KBASE(t) ((MODE == 1 ? NTF - 1 - (t) : (t)) * KVBLK)
#define MASKT(P0_, P1_, t) do { const int kb_ = KBASE(t); if (kb_ + KVBLK - 1 > qlimw) { asm volatile("; mask tile"); mask_tile(P0_, P1_, qm - kb_); } } while (0)
#define SEAM_K0() do { VMWN(8); SWRITE_HK(0); SBAR(); } while (0)
    f32x16 pA0, pA1, pB0, pB1; float mnA = 0.f, mnB = 0.f, alA = 1.f, alB = 1.f; bf16x8 pa0, pa1, pa2, pa3; (void)mnA; (void)mnB;
    if (wid >= 4) __builtin_amdgcn_s_setprio(1);
#define A_QKT(KB, X0, X1, t) qkt<KB, BIAS>(X0, X1, K_lds, r32, hi, S.qr, btab + KBASE(t))
#define A_PV(VB) pv_tile<VB>(o, vb0, pa0, pa1, pa2, pa3)
#define A_PSM(X0, X1, mnX, alX) do { if constexpr (FIXM) psm_fix(X0, X1, mnLf); else partialSM(X0, X1, m_reg, mnX, alX); } while (0)
#define A_FSM(Y0, Y1, alY) do { if constexpr (FIXM) fsm_fix(Y0, Y1, pa0, pa1, pa2, pa3); else finishSM(Y0, Y1, alY, l_reg, pa0, pa1, pa2, pa3); } while (0)
#define A_PVSM(VB, X0, X1, mnX, alX) do { if constexpr (FIXM) pv_smf<VB>(o, vb0, pa0, pa1, pa2, pa3, X0, X1, mnLf); else pv_sm<VB>(o, vb0, pa0, pa1, pa2, pa3, X0, X1, m_reg, mnX, alX); } while (0)
#define A_SLOAD(Kp, Vp, k0) SLOAD_H(Kp, Vp, k0)
#define A_SWRITE(bf) do { VMW(); SWRITE_H(bf); } while (0)
#define A_SYNC() __syncthreads()
    SWRITE_HV(0); SBAR();
    A_SLOAD(Kh, Vh, KBASE(1));
    SBAR(); A_QKT(0, pA0, pA1, 0);
    MASKT(pA0, pA1, 0); A_PSM(pA0, pA1, mnA, alA);
    A_SWRITE(1);
    A_SYNC();
#define HALF_STEP(PX0, PX1, mnX, alX, PY0, PY1, alY, t, KB, VB, SB) do {                                                      \
        SBAR(); A_QKT(KB, PX0, PX1, t);                                                                                      \
        A_FSM(PY0, PY1, alY); SBAR();                                                                                         \
        if ((t) + 1 < NT) { A_SLOAD(Kh, Vh, KBASE((t) + 1)); SBAR(); }                                                        \
        MASKT(PX0, PX1, (t)); A_PVSM(VB, PX0, PX1, mnX, alX);                                                                 \
        A_SYNC();                                                                                                             \
        if ((t) + 1 < NT) { A_SWRITE(SB); }                                                                                   \
        RESC(alX); A_SYNC(); } while (0)
    for (int t = 1; t + 1 < NT; t += 2) {
        HALF_STEP(pB0, pB1, mnB, alB, pA0, pA1, alA, t, 1, 0, 0);
        HALF_STEP(pA0, pA1, mnA, alA, pB0, pB1, alB, t + 1, 0, 1, 1);
    }
    SBAR(); A_QKT(1, pB0, pB1, NT - 1); SBAR();
    SLOAD_H(nxt.K, nxt.V, (MODE == 1 ? nxt.P0 + 3 * KVBLK : 0)); SBAR();
#pragma unroll
    for (int d0 = 0; d0 < 8; ++d0) S.qr[d0] = *(const bf16x8*)(nxt.Q + (size_t)(wid * QBLK + r32) * PITCH + d0 * 16 + hi * 8);
    SBAR();
    A_FSM(pA0, pA1, alA); SBAR();
    MASKT(pB0, pB1, NT - 1); A_PVSM(0, pB0, pB1, mnB, alB); __syncthreads(); RESC(alB);
    A_FSM(pB0, pB1, alB); SBAR(); A_PV(1);
    SBAR(); SEAM_K0();
    f32x16 tp[4]; int lane_e = lane; asm volatile("" : "+v"(lane_e));
    epi.prefetch(tp, cur, wid, lane_e);
    if constexpr (MODE == 0 && !FIXM) { if (hi == 0) stat[r32] = make_float2(m_reg, l_reg); }
    if (hi == 0) li_l[r32] = l_reg; asm volatile("s_waitcnt lgkmcnt(0)" ::: "memory");
#pragma unroll
    for (int r = 0; r < 16; ++r) { const float rl = __builtin_amdgcn_rcpf(li_l[crow(r, hi)]);
#pragma unroll
        for (int d0 = 0; d0 < 4; ++d0) o[d0][r] *= rl; }
    epi(o, tp, cur, lds, wid, lane_e);
    __builtin_amdgcn_s_setprio(0);
    __syncthreads();
#undef A_QKT
#undef A_PV
#undef A_PVSM
#undef A_PSM
#undef A_FSM
#undef A_SLOAD
#undef A_SWRITE
#undef A_SYNC
#undef RESC
#undef KBASE
#undef MASKT
#undef SEAM_K0
#undef HALF_STEP
}
#undef ROW
#undef VMW
#undef VMWN
#undef SLOAD_H
#undef SWRITE_HK
#undef SWRITE_HV
#undef SWRITE_H
template <int SM>
__device__ __forceinline__ void store_tile(const f32x16* val, char* lds, int wid, int lane, const bf16_t* __restrict__ gate, bf16_t* __restrict__ dst, unsigned rowbase  , int colbase, const float* __restrict__ colscale, const float* rowscale  ) {
    const int r32 = lane & 31, hi = lane >> 5; float* stg = (float*)(lds + OFF_STG) + wid * 2048;
    const int c4 = (lane & 15) * 4; const unsigned off0 = (rowbase + (unsigned)(lane >> 4)) * (unsigned)PITCH + (unsigned)(colbase + c4);
    uint2 g[2][8];
    if (SM >= 1) {
#pragma unroll
        for (int hh = 0; hh < 2; ++hh)
#pragma unroll
            for (int i = 0; i < 8; ++i) g[hh][i] = *(const uint2*)(gate + off0 + (unsigned)(4 * i) * PITCH + hh * 64); }
#pragma unroll
    for (int hh = 0; hh < 2; ++hh) {
#pragma unroll
        for (int r = 0; r < 16; ++r) { const int row = crow(r, hi); stg[row * 64 + r32] = val[2 * hh][r]; stg[row * 64 + 32 + r32] = val[2 * hh + 1][r]; }
        asm volatile("s_waitcnt lgkmcnt(0)" ::: "memory");
        f32x4 cs = (f32x4){1.f, 1.f, 1.f, 1.f}; if (SM == 2) cs = *(const f32x4*)(colscale + hh * 64 + c4);
#pragma unroll
        for (int i = 0; i < 8; ++i) { const int row = 4 * i + (lane >> 4); f32x4 v = *(const f32x4*)(stg + row * 64 + c4);
            if (SM == 2) { const float rsc = rowscale[row]; v = v * rsc * cs; }
            if (SM >= 1) { const uint2 gg = g[hh][i]; v[0] *= __uint_as_float(gg.x << 16); v[1] *= __uint_as_float(gg.x & 0xffff0000u); v[2] *= __uint_as_float(gg.y << 16); v[3] *= __uint_as_float(gg.y & 0xffff0000u); }
            uint2 w; w.x = cvtpk(v[0], v[1]); w.y = cvtpk(v[2], v[3]);
            *(uint2*)(dst + off0 + (unsigned)(4 * i) * PITCH + hh * 64) = w; }
        asm volatile("s_waitcnt lgkmcnt(0)" ::: "memory");
    }
}
__device__ __forceinline__ void rescale_rows(char* lds, int wid, int lane, const bf16_t* __restrict__ gate, bf16_t* dst, unsigned rowbase, int colbase, const float* __restrict__ colscale, const float* rowscale) {
    const int c4 = (lane & 15) * 4; const unsigned off0 = (rowbase + (unsigned)(lane >> 4)) * (unsigned)PITCH + (unsigned)(colbase + c4);
    uint2 a[2][8], g[2][8];
#pragma unroll
    for (int hh = 0; hh < 2; ++hh)
#pragma unroll
        for (int i = 0; i < 8; ++i) { a[hh][i] = *(const uint2*)(dst + off0 + (unsigned)(4 * i) * PITCH + hh * 64); g[hh][i] = *(const uint2*)(gate + off0 + (unsigned)(4 * i) * PITCH + hh * 64); }
#pragma unroll
    for (int hh = 0; hh < 2; ++hh) { const f32x4 cs = *(const f32x4*)(colscale + hh * 64 + c4);
#pragma unroll
        for (int i = 0; i < 8; ++i) { const float rsc = rowscale[4 * i + (lane >> 4)]; const uint2 aa = a[hh][i], gg = g[hh][i];
            uint2 w; w.x = cvtpk(__uint_as_float(aa.x << 16) * rsc * cs[0] * __uint_as_float(gg.x << 16), __uint_as_float(aa.x & 0xffff0000u) * rsc * cs[1] * __uint_as_float(gg.x & 0xffff0000u));
                     w.y = cvtpk(__uint_as_float(aa.y << 16) * rsc * cs[2] * __uint_as_float(gg.y << 16), __uint_as_float(aa.y & 0xffff0000u) * rsc * cs[3] * __uint_as_float(gg.y & 0xffff0000u));
            *(uint2*)(dst + off0 + (unsigned)(4 * i) * PITCH + hh * 64) = w; } }
}
struct EpiNullA { __device__ __forceinline__ void prefetch(f32x16*, const BlockRef&, int, int) const {}
    __device__ __forceinline__ void operator()(f32x16* o, f32x16*, const BlockRef&, char*, int, int) const { asm volatile("" :: "v"(o[0]), "v"(o[1]), "v"(o[2]), "v"(o[3])); } };
struct EpiFox { const bf16_t* G; bf16_t* AO;
    __device__ __forceinline__ void prefetch(f32x16*, const BlockRef&, int, int) const {}
    __device__ __forceinline__ void operator()(f32x16* o, f32x16*, const BlockRef& cur, char* lds, int wid, int lane) const {
        store_tile<1>(o, lds, wid, lane, G, AO, (unsigned)(cur.row0 + wid * QBLK), cur.head * 128, nullptr, nullptr); } };

__device__ __forceinline__ float half_sum32(float v) {
    v += __int_as_float(__builtin_amdgcn_ds_swizzle(__float_as_int(v), 0x041f)); v += __int_as_float(__builtin_amdgcn_ds_swizzle(__float_as_int(v), 0x081f));
    v += __int_as_float(__builtin_amdgcn_ds_swizzle(__float_as_int(v), 0x101f)); v += __int_as_float(__builtin_amdgcn_ds_swizzle(__float_as_int(v), 0x201f));
    v += __int_as_float(__builtin_amdgcn_ds_swizzle(__float_as_int(v), 0x401f)); return v;
}
struct EpiDiff { const bf16_t* G; bf16_t* AO; const float* gsub; float lam;
    __device__ __forceinline__ void prefetch(f32x16*, const BlockRef&, int, int) const {}
    __device__ __forceinline__ void operator()(f32x16* o, f32x16*, const BlockRef& cur, char* lds, int wid, int lane) const {
        const int r32 = lane & 31, hi = lane >> 5; const int step = cur.step;
        u32x4* sA = (u32x4*)(lds + OFF_STG + wid * 8192) + lane;
        float* ssq_l = (float*)(lds + OFF_SSQ) + wid * 32;
        const unsigned rowbase = (unsigned)(cur.row0 + wid * QBLK);
        if ((step & 1) == 0) {
#pragma unroll
            for (int k = 0; k < 8; ++k) { u32x4 w; w.x = cvtpk(o[0][2 * k], o[1][2 * k]); w.y = cvtpk(o[2][2 * k], o[3][2 * k]); w.z = cvtpk(o[0][2 * k + 1], o[1][2 * k + 1]); w.w = cvtpk(o[2][2 * k + 1], o[3][2 * k + 1]); sA[k * 64] = w; }
        } else {
            const bool fin = step == 3;
#pragma unroll
            for (int k = 0; k < 8; ++k) { const u32x4 w = sA[k * 64];
#pragma unroll
                for (int e = 0; e < 2; ++e) { const int r = 2 * k + e; const unsigned w0 = e ? w.z : w.x, w1 = e ? w.w : w.y;
                    const float d0_ = __uint_as_float(w0 << 16) - lam * o[0][r], d1_ = __uint_as_float(w0 & 0xffff0000u) - lam * o[1][r];
                    const float d2_ = __uint_as_float(w1 << 16) - lam * o[2][r], d3_ = __uint_as_float(w1 & 0xffff0000u) - lam * o[3][r];
                    o[0][r] = d0_; o[1][r] = d1_; o[2][r] = d2_; o[3][r] = d3_;
                    float p = half_sum32((d0_ * d0_ + d1_ * d1_) + (d2_ * d2_ + d3_ * d3_));
                    const float prev = ssq_l[crow(r, hi)]; asm volatile("s_waitcnt lgkmcnt(0)" ::: "memory");
                    const float val = fin ? 0.8f * __builtin_amdgcn_rsqf((p + prev) * (1.0f / 256.f) + 1e-6f) : p;
                    if (r32 == 0) ssq_l[crow(r, hi)] = val; } }
            asm volatile("s_waitcnt lgkmcnt(0)" ::: "memory");
            if (!fin) store_tile<0>(o, lds, wid, lane, nullptr, AO, rowbase, cur.head * 256, nullptr, nullptr);
            else { store_tile<2>(o, lds, wid, lane, G, AO, rowbase, cur.head * 256 + 128, gsub + 128, ssq_l);
                   rescale_rows(lds, wid, lane, G, AO, rowbase, cur.head * 256, gsub, ssq_l); }
        }
    } };
#undef KSWZ
#undef SBAR
}


__device__ __forceinline__ att::BlockRef diff_ref(int L, int s, const bf16_t* Q, const bf16_t* K, const bf16_t* V) {
    const int xcd = L & 7, k = L >> 3, bh = xcd * 8 + (k >> 2), pair = k & 3, b = bh >> 3, h = bh & 7, qb = (s >> 2) ? 7 - pair : pair, pass = s & 3, hh = 2 * h + (pass & 1);
    att::BlockRef r; r.P0 = qb * 256; r.row0 = b * SEQ + qb * 256; r.head = h; r.step = pass; r.jlo = 0;
    r.Q = Q + (size_t)r.row0 * DM + hh * 128; r.K = K + (size_t)b * SEQ * DM + hh * 128; r.V = V + (size_t)b * SEQ * DM + h * 256 + (pass >> 1) * 128; return r;
}
__device__ __forceinline__ int fox_head(int L, const int* ord) { const int g = (L >> 3) >> 2; return ord[g < 8 ? g : 23 - g]; }
__device__ __forceinline__ att::BlockRef fox_ref(int L, int pass, const int* ord, const bf16_t* Q, const bf16_t* K, const bf16_t* V) {
    const int b = L & 7, pair = (L >> 3) & 3, h = fox_head(L, ord), qb = pass ? 7 - pair : pair;
    att::BlockRef r; r.P0 = qb * 256; r.row0 = b * SEQ + qb * 256; r.head = h; r.step = pass; r.jlo = 0;
    r.Q = Q + (size_t)r.row0 * DM + h * 128; r.K = K + (size_t)b * SEQ * DM + h * 128; r.V = V + (size_t)b * SEQ * DM + h * 128; return r;
}
__device__ __forceinline__ void fox_setup(const float* __restrict__ fb, const float* __restrict__ gq, const float* __restrict__ gk, char* lds, const int wave_s) {
    const int lane = lane_id_v(); int* ord = (int*)(lds + att::OFF_SSQ + 1024 + 64); float* tr = (float*)(lds + att::OFF_SSQ + 1024 + 128);
    if (wave_s == 0) {
        float mq = fmaxf(fabsf(gq[lane]), fabsf(gq[lane + 64])), mk = fmaxf(fabsf(gk[lane]), fabsf(gk[lane + 64]));
#pragma unroll
        for (int o = 1; o < 64; o <<= 1) { mq = fmaxf(mq, __shfl_xor(mq, o)); mk = fmaxf(mk, __shfl_xor(mk, o)); }
        if (lane < 16) { const float me = fb[lane]; int rank = 0;
#pragma unroll
            for (int j = 0; j < 16; ++j) { const float o = fb[j]; rank += (o < me || (o == me && j < lane)) ? 1 : 0; }
            ord[rank] = lane; }
        if (lane == 0) tr[0] = 50.0f / att::SCALE + 2.0f * 1.01f * 128.0f * mq * mk;
    }
    __syncthreads();
}
__device__ __forceinline__ int fox_jlo(int P0, char* lds) {
    const int lane = lane_id_v(); const float* tab = (const float*)(lds + att::OFF_BIAS); const float thr = tab[P0] - *(const float*)(lds + att::OFF_SSQ + 1024 + 128);
    const bool skip = lane < (P0 >> 6) && tab[(lane & 31) * 64 + 63] < thr;
    return (int)__builtin_popcountll(__ballot(skip)) & ~1;
}
__device__ __forceinline__ void fox_bias(const float* __restrict__ lf, char* lds, const int wave_s) {
    const int tid = make_tid(wave_s);
    float* tab = (float*)(lds + att::OFF_BIAS); float* wt = (float*)(lds + att::OFF_SSQ + 1024);
    const int lane = tid & 63, wave = tid >> 6;
    const f32x4 v = *(const f32x4*)(lf + 4 * tid);
    const float a0 = v[0], a1 = a0 + v[1], a2 = a1 + v[2], a3 = a2 + v[3];
    float tot = a3;
#pragma unroll
    for (int o = 1; o < 64; o <<= 1) { const float t = __int_as_float(__builtin_amdgcn_ds_bpermute((lane >= o ? lane - o : lane) << 2, __float_as_int(tot))); if (lane >= o) tot += t; }
    if (lane == 63) wt[wave] = tot;
    __syncthreads();
    float base = tot - a3;
    for (int w = 0; w < wave; ++w) base += wt[w];
    const float ns = -1.0f / att::SCALE;
    *(f32x4*)(tab + 4 * tid) = (f32x4){(base + a0) * ns, (base + a1) * ns, (base + a2) * ns, (base + a3) * ns};
    __syncthreads();
}

#define XB_TMO      128
#define XB_XCNT(j)  (256  + 64 * (j))
#define XB_XSUB(j)  (1280 + 64 * (j))
#define XB_XGEN(j)  (2304 + 64 * (j))
#define XB_TOP      3328
#define XB_TOPGEN   3392
#define XCD_BAR_WORDS 8192
#define GB_CNT(g)   (4096 + 64 * (g))
#define GB_GEN(g)   (4608 + 64 * (g))
#define GB_MASK(g)  (5120 + 64 * (g))
#define GB_NPOST(g) (5632 + 64 * (g))
#define XB_SPIN_CAP (1u << 22)
__device__ __forceinline__ unsigned xb_ld(unsigned* p)              { return __hip_atomic_load(p, __ATOMIC_RELAXED, __HIP_MEMORY_SCOPE_AGENT); }
__device__ __forceinline__ unsigned xb_add(unsigned* p, unsigned v) { return __hip_atomic_fetch_add(p, v, __ATOMIC_RELAXED, __HIP_MEMORY_SCOPE_AGENT); }
__device__ __forceinline__ unsigned xb_xcc_id() { return (unsigned)__builtin_amdgcn_s_getreg((3 << 11) | 20) & 0xFu; }
#define XB_SPIN(cond, bar) do { unsigned _sp = 0; while (cond) { __builtin_amdgcn_s_sleep(1); \
    if ((++_sp & 255u) == 0u) { if (xb_ld(&(bar)[XB_TMO])) break; if (_sp > XB_SPIN_CAP) { atomicAdd(&(bar)[XB_TMO], 1u); break; } } } } while (0)
struct XcdBarrier { unsigned* bar; unsigned x; volatile LAS unsigned* st; };
__device__ __forceinline__ void xcd_barrier_complete(unsigned* bar, unsigned x, unsigned G, unsigned& nloc, unsigned& nx) {
    unsigned sum, cnt, mine, sp = 0u;
    for (;;) {
        sum = 0u; cnt = 0u; mine = 0u;
#pragma unroll
        for (unsigned j = 0; j < 16; ++j) { const unsigned c = xb_ld(&bar[XB_XCNT(j)]); sum += c; cnt += (c > 0u) ? 1u : 0u; mine = (j == x) ? c : mine; }
        if (sum == G) break;
        __builtin_amdgcn_s_sleep(1);
        if ((++sp & 255u) == 0u) { if (xb_ld(&bar[XB_TMO])) break; if (sp > XB_SPIN_CAP) { atomicAdd(&bar[XB_TMO], 1u); break; } }
    }
    nloc = mine > 0u ? mine : 1u; nx = cnt > 0u ? cnt : 1u;
}
__device__ __forceinline__ void xcd_barrier(const XcdBarrier& b, const int tid, const unsigned G) {
    asm volatile("s_waitcnt vmcnt(0)" ::: "memory");
    __syncthreads();
    if (tid == 0) {
        unsigned* bar = b.bar;
        __builtin_amdgcn_s_waitcnt(0);
        unsigned nloc = b.st[0], nx = b.st[1];
        if (nloc == 0u) { xcd_barrier_complete(bar, b.x, G, nloc, nx); b.st[0] = nloc; b.st[1] = nx; }
        const unsigned old = xb_add(&bar[XB_XSUB(b.x)], 1u);
        const unsigned gen = old / nloc;
        if (old + 1u == (gen + 1u) * nloc) {
            __builtin_amdgcn_fence(__ATOMIC_RELEASE, "agent");
            asm volatile("s_waitcnt vmcnt(0)" ::: "memory");
            const unsigned og = xb_add(&bar[XB_TOP], 1u);
            const unsigned tg = og / nx;
            if (og + 1u == (tg + 1u) * nx) xb_add(&bar[XB_TOPGEN], 1u);
            else XB_SPIN(xb_ld(&bar[XB_TOPGEN]) == tg, bar);
            __builtin_amdgcn_fence(__ATOMIC_ACQUIRE, "agent");
            xb_add(&bar[XB_XGEN(b.x)], 1u);
            asm volatile("s_waitcnt vmcnt(0)" ::: "memory");
        } else {
            XB_SPIN(xb_ld(&bar[XB_XGEN(b.x)]) == gen, bar);
            __builtin_amdgcn_fence(__ATOMIC_ACQUIRE, "agent");
            asm volatile("s_waitcnt vmcnt(0)" ::: "memory");
        }
    }
    __syncthreads();
}
__device__ __forceinline__ void grp_barrier(unsigned* bar, const int g, const unsigned nmem, volatile LAS unsigned* st, const int tid) {
    asm volatile("s_waitcnt vmcnt(0)" ::: "memory");
    __syncthreads();
    if (tid == 0) {
        __builtin_amdgcn_s_waitcnt(0);
        unsigned mode = st[2];
        if (mode == 0u) {
            const unsigned np = xb_ld(&bar[GB_NPOST(g)]), m = xb_ld(&bar[GB_MASK(g)]);
            if (np == nmem) { mode = (__builtin_popcount(m) == 1) ? 1u : 2u; st[2] = mode; } else mode = 2u; }
        if (mode != 1u) { __builtin_amdgcn_fence(__ATOMIC_RELEASE, "agent"); asm volatile("s_waitcnt vmcnt(0)" ::: "memory"); }
        const unsigned old = xb_add(&bar[GB_CNT(g)], 1u);
        const unsigned gen = old / nmem;
        if (old + 1u == (gen + 1u) * nmem) xb_add(&bar[GB_GEN(g)], 1u);
        else XB_SPIN(xb_ld(&bar[GB_GEN(g)]) == gen, bar);
        __builtin_amdgcn_fence(__ATOMIC_ACQUIRE, "agent");
        asm volatile("s_waitcnt vmcnt(0)" ::: "memory");
    }
    __syncthreads();
}
constexpr size_t WS_BAR = 256 * 1024;
constexpr int LDS_CTL = LDS_BYTES - 64;
struct Args { const void* in[18]; float* out; unsigned char* ws; int ph_lo, ph_hi, li, pad; };

__device__ __forceinline__ unsigned pk2(float lo, float hi) { return (unsigned)f2bf(lo) | ((unsigned)f2bf(hi) << 16); }

struct P0Item { const float* W; const float* g; bf16_t* Wt; int ldw, N, k0, n0; };
__device__ __forceinline__ void p0_decode(int r, const Args& a, unsigned char* ws, P0Item& I) {
    constexpr int I1 = 32 * 128, I2 = 32 * 32, I3 = 32 * 129;
    int nblk;
    if (r < I1) { I.W = (const float*)a.in[3]; I.g = (const float*)a.in[2]; I.Wt = (bf16_t*)(ws + WS_W1T); I.ldw = NQKVG; I.N = NQKVG; nblk = 128; }
    else if (r < I1 + I2) { r -= I1; I.W = (const float*)a.in[11]; I.g = nullptr; I.Wt = (bf16_t*)(ws + WS_W2T); I.ldw = DM; I.N = DM; nblk = 32; }
    else if (r < I1 + I2 + I3) { r -= I1 + I2; I.W = (const float*)a.in[13]; I.g = (const float*)a.in[12]; I.Wt = (bf16_t*)(ws + WS_W3T); I.ldw = NQKVG + NFG; I.N = NQKVG + NFG; nblk = 129; }
    else { r -= I1 + I2 + I3; I.W = (const float*)a.in[17]; I.g = nullptr; I.Wt = (bf16_t*)(ws + WS_W4T); I.ldw = DM; I.N = DM; nblk = 32; }
    const int kb = r / nblk; I.k0 = kb * 64; I.n0 = (r - kb * nblk) * 64;
}
__device__ __forceinline__ void p0_load(const P0Item& I, int lane, f32x4 (&v)[16], float (&gv)[16]) {
    const int c4 = (lane & 15) * 4, kr = lane >> 4; const bool in = I.n0 + c4 < I.N;
    const float* p = I.W + (size_t)(I.k0 + kr) * I.ldw + I.n0 + c4;
#pragma unroll
    for (int i = 0; i < 16; ++i) { v[i] = in ? *(const f32x4*)(p + (size_t)(4 * i) * I.ldw) : (f32x4){0.f, 0.f, 0.f, 0.f}; gv[i] = I.g ? I.g[I.k0 + 4 * i + kr] : 1.0f; }
}
__device__ __forceinline__ void p0_emit(const P0Item& I, int lane, const f32x4 (&v)[16], const float (&gv)[16], LAS float* scr) {
    const int c4 = (lane & 15) * 4, kr = lane >> 4;
#pragma unroll
    for (int i = 0; i < 16; ++i) { LAS float* s = scr + (4 * i + kr) * 65 + c4; s[0] = v[i].x * gv[i]; s[1] = v[i].y * gv[i]; s[2] = v[i].z * gv[i]; s[3] = v[i].w * gv[i]; }
    asm volatile("s_waitcnt lgkmcnt(0)" ::: "memory");
    const int c = lane & 7;
#pragma unroll
    for (int j = 0; j < 8; ++j) { const int n = (lane >> 3) + 8 * j; const LAS float* s = scr + (8 * c) * 65 + n;
        uint4 o; o.x = pk2(s[0], s[65]); o.y = pk2(s[2 * 65], s[3 * 65]); o.z = pk2(s[4 * 65], s[5 * 65]); o.w = pk2(s[6 * 65], s[7 * 65]);
        if (I.n0 + n < I.N) *(uint4*)(I.Wt + (size_t)(I.n0 + n) * DM + I.k0 + 8 * c) = o; }
    asm volatile("s_waitcnt lgkmcnt(0)" ::: "memory");
}

__global__ void __launch_bounds__(NTHREADS, 2) mk_fwd(Args a) {
    extern __shared__ __attribute__((aligned(16))) unsigned char lds_raw[];
    LAS unsigned char* lds = (LAS unsigned char*)lds_raw;
    cg::grid_group grid = cg::this_grid();
    const int G = gridDim.x, bx = blockIdx.x;
    if (a.ph_lo < 0) grid.sync();
    const int wave_s = __builtin_amdgcn_readfirstlane((int)threadIdx.x >> 6);
    if (threadIdx.x < 16) ((LAS unsigned*)(lds + LDS_CTL))[threadIdx.x] = 0u;
    __syncthreads();
    XcdBarrier xbar; xbar.bar = (unsigned*)(a.ws + WS_BAR) + a.li * XCD_BAR_WORDS; xbar.x = xb_xcc_id(); xbar.st = (volatile LAS unsigned*)(lds + LDS_CTL);
    if (threadIdx.x == 0) { (void)xb_add(&xbar.bar[XB_XCNT(xbar.x)], 1u); (void)__hip_atomic_fetch_or(&xbar.bar[GB_MASK(bx & 7)], 1u << xbar.x, __ATOMIC_RELAXED, __HIP_MEMORY_SCOPE_AGENT);
                            __builtin_amdgcn_s_waitcnt(0); (void)xb_add(&xbar.bar[GB_NPOST(bx & 7)], 1u); }
#define GRID_BAR() do { PHASE_IDS(); xcd_barrier(xbar, tid, (unsigned)G); } while (0)
#define GROUP_BAR() do { PHASE_IDS(); if (G == 256) grp_barrier(xbar.bar, bx & 7, 32u, xbar.st, tid); else xcd_barrier(xbar, tid, (unsigned)G); } while (0)
#define PHASE_IDS() const int lane = lane_id_v(), wave = wave_s; const int tid = wave_s * 64 + lane; (void)wave
    unsigned char* ws = a.ws;
    const int lo = a.ph_lo, hi = a.ph_hi;
#if defined(ONLY_PHASE)
#define IN(k) ((k) == ONLY_PHASE && lo <= (k) && (k) < hi)
#elif defined(SKIP_PHASE)
#define IN(k) ((k) != SKIP_PHASE && lo <= (k) && (k) < hi)
#else
#define IN(k) (lo <= (k) && (k) < hi)
#endif
#define BOTH(k) (IN(k) && IN((k) + 1))
#ifdef REPEAT_PHASE
#define REP(k) for (int rep_ = 0; rep_ < ((k) == REPEAT_PHASE ? 2 : 1); ++rep_)
#else
#define REP(k)
#endif
    if (IN(0)) REP(0) {
        PHASE_IDS();
        const int gw = bx * NWAVES + wave, NGW = G * NWAVES;
        LAS float* scr = (LAS float*)(lds + wave * 16640);
        constexpr int NIT = 32 * 128 + 32 * 32 + 32 * 129 + 32 * 32;
        if (gw < NIT) {
            int it = gw; P0Item cur; f32x4 v[16]; float gv[16];
            p0_decode(it, a, ws, cur); p0_load(cur, lane, v, gv);
            for (;;) {
                const int itn = it + NGW; const bool more = itn < NIT;
                P0Item nxt = cur; f32x4 vn[16]; float gn[16];
                if (more) { p0_decode(itn, a, ws, nxt); p0_load(nxt, lane, vn, gn); }
                p0_emit(cur, lane, v, gv, scr);
                if (!more) break;
                cur = nxt; it = itn;
#pragma unroll
                for (int i = 0; i < 16; ++i) { v[i] = vn[i]; gv[i] = gn[i]; }
            }
        }
        { const float* x = (const float*)a.in[0]; bf16_t* xb = (bf16_t*)(ws + WS_XB);
          int row = gw; f32x4 v[8];
          if (row < M) {
            { const f32x4* xr = (const f32x4*)(x + (size_t)row * DM) + lane;
#pragma unroll
              for (int j = 0; j < 8; ++j) v[j] = xr[64 * j]; }
            for (;;) {
                const int rown = row + NGW; const bool more = rown < M; f32x4 vn[8];
                if (more) { const f32x4* xr = (const f32x4*)(x + (size_t)rown * DM) + lane;
#pragma unroll
                    for (int j = 0; j < 8; ++j) vn[j] = xr[64 * j]; }
                float s = 0.f;
#pragma unroll
                for (int j = 0; j < 8; ++j) s += v[j].x * v[j].x + v[j].y * v[j].y + v[j].z * v[j].z + v[j].w * v[j].w;
#pragma unroll
                for (int o = 1; o < 64; o <<= 1) s += __shfl_xor(s, o);
                const float rs = 1.0f / sqrtf(s * (1.0f / DM) + EPS);
                uint2* o8 = (uint2*)(xb + (size_t)row * DM) + lane;
#pragma unroll
                for (int j = 0; j < 8; ++j) { uint2 w; w.x = pk2(v[j].x * rs, v[j].y * rs); w.y = pk2(v[j].z * rs, v[j].w * rs); o8[64 * j] = w; }
                if (!more) break;
                row = rown;
#pragma unroll
                for (int j = 0; j < 8; ++j) v[j] = vn[j];
            } } }
        { const int* pos = (const int*)a.in[1];
          for (int idx = bx * NTHREADS + tid; idx < M * 16; idx += G * NTHREADS) {
            const int row = idx >> 4, i = idx & 15;
            const float inv_freq = (float)exp(-(double)i / 16.0 * log(500000.0));
            float c, s; sincos_acc((float)pos[row] * inv_freq, c, s);
            ((float*)(ws + WS_ROPE_COS))[idx] = c; ((float*)(ws + WS_ROPE_SIN))[idx] = s; }
          if (bx == 0 && wave == 0) {
            const float* lq1 = (const float*)a.in[6]; const float* lk1 = (const float*)a.in[7]; const float* lq2 = (const float*)a.in[8]; const float* lk2 = (const float*)a.in[9];
            float p = lq1[lane] * lk1[lane] + lq1[lane + 64] * lk1[lane + 64], q = lq2[lane] * lk2[lane] + lq2[lane + 64] * lk2[lane + 64];
#pragma unroll
            for (int o = 1; o < 64; o <<= 1) { p += __shfl_xor(p, o); q += __shfl_xor(q, o); }
            if (lane == 0) ((float*)(ws + WS_MISC))[0] = expf(p) - expf(q) + LAMBDA_INIT; } }
        if (BOTH(0)) GRID_BAR();
    }

    if (IN(1)) REP(1) {
        PHASE_IDS();
#ifdef PROBE_GEMM_NOEPI
        { pg8::Gemm g{(const bf16_t*)(ws + WS_XB), (const bf16_t*)(ws + WS_W1T), M, NQKVG, DM}; pg8::StaticOrder S; S.init(M, NQKVG, G, bx, WGM_BIG); pg8::EpiNull E;
          pg8::gemm_phase<pg8::EpiNull, pg8::StaticOrder, true, PG8_SP2>(lds, g, S, E, tid); }
#endif
        pg8::Gemm g{(const bf16_t*)(ws + WS_XB), (const bf16_t*)(ws + WS_W1T), M, NQKVG, DM}; pg8::StaticOrder S; S.init(M, NQKVG, G, bx, WGM_BIG);
        pg8::EpiQKVG<true, false> E{(bf16_t*)(ws + WS_Q), (bf16_t*)(ws + WS_K), (bf16_t*)(ws + WS_V), (bf16_t*)(ws + WS_G), (const float*)(ws + WS_MISC + 65536),
                                    (const float*)a.in[4], (const float*)a.in[5], (const float*)(ws + WS_ROPE_COS), (const float*)(ws + WS_ROPE_SIN), (LAS float*)(lds + EPI_OFF)};
        pg8::gemm_phase<pg8::EpiQKVG<true, false>, pg8::StaticOrder, true, PG8_SP2>(lds, g, S, E, tid);
        if (BOTH(1)) GROUP_BAR();
    }
    if (IN(2)) REP(2) {
        char* ldsg = (char*)lds_raw;
        const bf16_t* Qb = (const bf16_t*)(ws + WS_Q); const bf16_t* Kb = (const bf16_t*)(ws + WS_K); const bf16_t* Vb = (const bf16_t*)(ws + WS_V);
        const att::EpiDiff epi{(const bf16_t*)(ws + WS_G), (bf16_t*)(ws + WS_AO), (const float*)a.in[10], *(const float*)(ws + WS_MISC)};
        constexpr int NITEMS = 256;
        if (bx < NITEMS) {
            att::Seam S; att::BlockRef cur = diff_ref(bx, 0, Qb, Kb, Vb);
            att::attn_prime<0>(cur, ldsg, S, wave_s);
            for (int L = bx; L < NITEMS; L += G)
                for (int qsel = 0; qsel < 2; ++qsel) {
                    for (int p = 0; p < 2; ++p) { const int s = qsel * 4 + p;
                        const att::BlockRef nxt = diff_ref(L, s + 1, Qb, Kb, Vb);
                        att::attn_block<0, att::EpiDiff, false>(cur, nxt, ldsg, S, epi, wave_s); cur = nxt; }
                    for (int p = 2; p < 4; ++p) { const int s = qsel * 4 + p; const bool last_of_item = s == 7, more_item = L + G < NITEMS;
                        const att::BlockRef nxt = !last_of_item ? diff_ref(L, s + 1, Qb, Kb, Vb) : (more_item ? diff_ref(L + G, 0, Qb, Kb, Vb) : cur);
                        att::attn_block<0, att::EpiDiff, true>(cur, nxt, ldsg, S, epi, wave_s); cur = nxt; }
                }
        }
        if (BOTH(2)) GROUP_BAR();
    }
    if (IN(3)) REP(3) {
        PHASE_IDS();
        pg8::Gemm g{(const bf16_t*)(ws + WS_AO), (const bf16_t*)(ws + WS_W2T), M, DM, DM}; pg8::StaticOrder S; S.init(M, DM, G, bx, WGM_SMALL);
        pg8::EpiResMid E{(const float*)a.in[0], (bf16_t*)(ws + WS_XB), (float*)(ws + WS_SSQP), (LAS float*)(lds + EPI_OFF)};
        pg8::gemm_phase<pg8::EpiResMid, pg8::StaticOrder, true, PG8_SP2>(lds, g, S, E, tid);
        if (BOTH(3)) GROUP_BAR();
    }
    if (IN(4)) REP(4) {
        PHASE_IDS();
        {
            const bf16_t* xb = (const bf16_t*)(ws + WS_XB); const bf16_t* wf = (const bf16_t*)(ws + WS_W3T) + (size_t)NQKVG * DM;
            const float* ssqp = (const float*)(ws + WS_SSQP); float* logf_ = (float*)(ws + WS_LOGF); const float* fb = (const float*)a.in[14];
            LAS float* P = (LAS float*)(lds + EPI_OFF);
            for (int rr = bx; rr < M / 64; rr += G) { const int r0 = (G == 256) ? (rr & 7) * SEQ + (rr >> 3) * 64 : rr * 64;
                const int mt = wave & 3, kh = wave >> 2, ar = lane & 15, kq = lane >> 4;
                const bf16_t* ap = xb + (size_t)(r0 + 16 * mt + ar) * DM + kh * 1024 + 8 * kq; const bf16_t* bp = wf + (size_t)ar * DM + kh * 1024 + 8 * kq;
                f32x4 c = (f32x4){0.f, 0.f, 0.f, 0.f};
#pragma unroll 8
                for (int k = 0; k < 1024; k += 32) c = __builtin_amdgcn_mfma_f32_16x16x32_bf16(*(const bf16x8*)(ap + k), *(const bf16x8*)(bp + k), c, 0, 0, 0);
                if (kh == 1) { *(LAS f32x4*)(P + (mt * 64 + lane) * 4) = c; }
                __syncthreads();
                if (kh == 0) { const f32x4 o = *(const LAS f32x4*)(P + (mt * 64 + lane) * 4); const float b = fb[ar];
#pragma unroll
                    for (int j = 0; j < 4; ++j) { const int row = r0 + 16 * mt + 4 * kq + j;
                        const f32x4 pa = *(const f32x4*)(ssqp + (size_t)row * 8), pb = *(const f32x4*)(ssqp + (size_t)row * 8 + 4);
                        const float rs = 1.0f / sqrtf(((pa[0] + pa[1]) + (pa[2] + pa[3]) + (pb[0] + pb[1]) + (pb[2] + pb[3])) * (1.0f / 2048.f) + EPS);
                        const float z = (c[j] + o[j]) * rs + b;
                        logf_[((size_t)(row >> 11) * 16 + ar) * SEQ + (row & (SEQ - 1))] = fminf(z, 0.f) - log1pf(expf(-fabsf(z))); } }
                __syncthreads();
            }
        }
        pg8::Gemm g{(const bf16_t*)(ws + WS_XB), (const bf16_t*)(ws + WS_W3T), M, NQKVG, DM}; pg8::StaticOrder S; S.init(M, NQKVG, G, bx, WGM_BIG);
        pg8::EpiQKVG<false, true> E{(bf16_t*)(ws + WS_Q), (bf16_t*)(ws + WS_K), (bf16_t*)(ws + WS_V), (bf16_t*)(ws + WS_G), (const float*)(ws + WS_SSQP),
                                    (const float*)a.in[15], (const float*)a.in[16], nullptr, nullptr, (LAS float*)(lds + EPI_OFF)};
        pg8::gemm_phase<pg8::EpiQKVG<false, true>, pg8::StaticOrder, true, PG8_SP2>(lds, g, S, E, tid);
        if (BOTH(4)) GROUP_BAR();
    }
    if (IN(5)) REP(5) {
        char* ldsg = (char*)lds_raw;
        const bf16_t* Qb = (const bf16_t*)(ws + WS_Q); const bf16_t* Kb = (const bf16_t*)(ws + WS_K); const bf16_t* Vb = (const bf16_t*)(ws + WS_V);
        const att::EpiFox epi{(const bf16_t*)(ws + WS_G), (bf16_t*)(ws + WS_AO)};
        constexpr int NITEMS = 512;
        const int* ord = (const int*)(ldsg + att::OFF_SSQ + 1024 + 64);
        fox_setup((const float*)a.in[14], (const float*)a.in[15], (const float*)a.in[16], ldsg, wave_s);
        int L = bx, pass = 0;
        if (L < NITEMS) {
            att::Seam S; att::BlockRef cur = fox_ref(L, 0, ord, Qb, Kb, Vb);
            att::attn_prime<1>(cur, ldsg, S, wave_s);
            for (;;) {
                const bool more_pass = pass == 0, more_item = L + G < NITEMS, last = !more_pass && !more_item;
                const int Ln = more_pass ? L : (more_item ? L + G : L), passn = more_pass ? 1 : 0;
                const att::BlockRef nxt = last ? cur : fox_ref(Ln, passn, ord, Qb, Kb, Vb);
                if (pass == 0) fox_bias((const float*)(ws + WS_LOGF) + (size_t)((L & 7) * 16 + cur.head) * SEQ, ldsg, wave_s);
                cur.jlo = __builtin_amdgcn_readfirstlane(fox_jlo(cur.P0, ldsg));
                att::attn_block<1>(cur, nxt, ldsg, S, epi, wave_s);
                if (last) break;
                cur = nxt; L = Ln; pass = passn;
            }
        }
        if (BOTH(5)) GROUP_BAR();
    }
    if (IN(6)) {
        PHASE_IDS();
        pg8::Gemm g{(const bf16_t*)(ws + WS_AO), (const bf16_t*)(ws + WS_W4T), M, DM, DM}; pg8::StaticOrder S; S.init(M, DM, G, bx, WGM_SMALL);
        pg8::EpiResOut E{(const bf16_t*)(ws + WS_XB), a.out};
        pg8::gemm_phase<pg8::EpiResOut, pg8::StaticOrder, true, PG8_SP2>(lds, g, S, E, tid);
    }
#undef IN
#undef BOTH
}

static int mk_grid() {
    static int grid = 0;
    if (grid == 0) {
        int dev = 0, cus = 0, per_cu = 0;
        if (hipGetDevice(&dev) != hipSuccess || hipDeviceGetAttribute(&cus, hipDeviceAttributeMultiprocessorCount, dev) != hipSuccess) { fprintf(stderr, "mk: device query failed\n"); grid = -1; return grid; }
        if (hipFuncSetAttribute((const void*)mk_fwd, hipFuncAttributeMaxDynamicSharedMemorySize, LDS_BYTES) != hipSuccess) { fprintf(stderr, "mk: hipFuncSetAttribute failed\n"); grid = -1; return grid; }
        if (hipOccupancyMaxActiveBlocksPerMultiprocessor(&per_cu, (const void*)mk_fwd, NTHREADS, LDS_BYTES) != hipSuccess || per_cu < 1) { fprintf(stderr, "mk: occupancy query says %d\n", per_cu); grid = -1; return grid; }
        (void)hipGetLastError();
        grid = cus;
        fprintf(stderr, "mk: cus %d per_cu %d grid %d\n", cus, per_cu, grid);
    }
    return grid;
}
static void mk_launch(void* const* d_in, void* d_out, void* d_ws, int ph_lo, int ph_hi, int li, hipStream_t stream) {
    const int grid = mk_grid(); if (grid <= 0) return;
    Args a{}; for (int i = 0; i < 18; ++i) a.in[i] = d_in[i];
    a.out = (float*)d_out; a.ws = (unsigned char*)d_ws; a.ph_lo = ph_lo; a.ph_hi = ph_hi; a.li = li;
    void* args[] = {&a};
    hipError_t e = hipLaunchCooperativeKernel((const void*)mk_fwd, dim3(grid), dim3(NTHREADS), args, LDS_BYTES, stream);
    if (e != hipSuccess) fprintf(stderr, "mk: cooperative launch failed: %s\n", hipGetErrorString(e));
}

extern "C" void kernel_launch(void* const* d_in, const int* in_sizes, int n_in, void* d_out, int out_size, void* d_ws, size_t ws_size, hipStream_t stream) {
    if (n_in != 18 || in_sizes[0] != M * DM || out_size != M * DM || ws_size < WS_END) { fprintf(stderr, "kernel_launch: unexpected shapes (n_in %d, in0 %d, out %d, ws %zu)\n", n_in, n_in > 0 ? in_sizes[0] : -1, out_size, ws_size); return; }
    (void)hipMemsetAsync((char*)d_ws + WS_BAR, 0, 4 * XCD_BAR_WORDS * 4, stream);
#ifdef PROBE_PHASE
    mk_launch(d_in, d_out, d_ws, 0, PROBE_PHASE + 1, 0, stream); mk_launch(d_in, d_out, d_ws, PROBE_PHASE, 7, 1, stream);
#else
    mk_launch(d_in, d_out, d_ws, 0, 7, 0, stream);
#endif
}
```

```cpp
#include <hip/hip_runtime.h>
#include <hip/hip_cooperative_groups.h>
#include <cstdio>
#include <cstdint>

typedef unsigned short bf16_t;
typedef short bf16x8 __attribute__((ext_vector_type(8)));
typedef float f32x4 __attribute__((ext_vector_type(4)));

constexpr int NB = 8, SEQ = 2048, DM = 2048, M = NB * SEQ;
constexpr int NQKVG = 8192, NFG = 16;
constexpr float EPS = 1e-6f;
constexpr float LAMBDA_INIT = 0.2f;
constexpr float ATT_SCALE = 0.08838834764831845f;

constexpr size_t MiB = 1u << 20;
constexpr size_t WS_MISC = 0;
constexpr size_t WS_ROPE_COS = 1 * MiB, WS_ROPE_SIN = 2 * MiB, WS_LOGF = 3 * MiB, WS_CUM = 4 * MiB;
constexpr size_t WS_W1T = 8 * MiB, WS_W2T = 40 * MiB, WS_W3T = 48 * MiB, WS_W4T = 81 * MiB;
constexpr size_t WS_XB = 96 * MiB, WS_Q = 160 * MiB, WS_K = 224 * MiB, WS_V = 288 * MiB, WS_G = 352 * MiB, WS_AO = 416 * MiB, WS_END = 480 * MiB;

__device__ __forceinline__ unsigned short f2bf(float f) { unsigned u = __float_as_uint(f); return (unsigned short)((u + 0x7fffu + ((u >> 16) & 1u)) >> 16); }
__device__ __forceinline__ float bf2f(unsigned short h) { return __uint_as_float((unsigned)h << 16); }

__device__ __forceinline__ void sincos_acc(float ang, float& c, float& s) {
    const double a = (double)ang, twopi = 6.283185307179586476925286766559;
    const double r = a - rint(a / twopi) * twopi; const double r2 = r * r;
    double ts = r, tc = 1.0, ss = r, cs = 1.0;
#pragma unroll
    for (int i = 1; i <= 14; ++i) { tc *= -r2 / (double)((2 * i - 1) * (2 * i)); ts *= -r2 / (double)((2 * i) * (2 * i + 1)); cs += tc; ss += ts; }
    c = (float)cs; s = (float)ss;
}

namespace pg8 {
#define PG8_LAS __attribute__((address_space(3)))
typedef unsigned short bf16_t;
typedef short bf16x8 __attribute__((ext_vector_type(8)));
typedef float f32x4 __attribute__((ext_vector_type(4)));
typedef unsigned u32x4 __attribute__((ext_vector_type(4)));
constexpr int BM = 256, BK = 64, HALF = 128, HTB = HALF * BK * 2  , STAGE_BYTES = 8 * HTB, NXCD = 8, WGM = 8;

__host__ __device__ __forceinline__ int lds_byte(int r, int c) { const int st = (r >> 4) * 2 + (c >> 5), rr = r & 15, cc = c & 31, ob = rr * 64 + cc * 2; return st * 1024 + (ob ^ (((ob >> 9) & 1) << 5)); }
__host__ __device__ __forceinline__ void stage_rc(int b, int& R, int& C) { const int st = b / 1024, sb = b % 1024, swz = sb ^ (((sb >> 9) & 1) << 5); R = (st >> 1) * 16 + swz / 64; C = (st & 1) * 32 + (swz % 64) / 2; }
__host__ __device__ __forceinline__ int perm32(int rho) { const int n = rho >> 4, i = rho & 15; return 8 * (i >> 2) + 4 * n + (i & 3); }

struct Unit { int pm, pn; };
struct Gemm { const bf16_t* A; const bf16_t* Bt; int M, N, K; };

struct StaticOrder {
    int nM, nN, nwg, G, c, wgm;
    __host__ __device__ void init(int M, int N, int G_, int c_, int wgm_ = WGM) { nM = M / BM; nN = N / BM; nwg = nM * nN; G = G_; c = c_; wgm = wgm_; }
    __host__ __device__ bool next(int i, Unit& u) const {
        const long L = (long)i * G + c; if (L >= nwg) return false;
        int wgid = (int)L; { const int q = nwg / NXCD, r = nwg % NXCD, xcd = wgid % NXCD, off = wgid / NXCD; wgid = (xcd < r ? xcd * (q + 1) : r * (q + 1) + (xcd - r) * q) + off; }
        const int nig = wgm * nN, gid = wgid / nig, fm = gid * wgm, gsz = (nM - fm) < wgm ? (nM - fm) : wgm;
        u.pm = fm + ((wgid % nig) % gsz); u.pn = (wgid % nig) / gsz; return true;
    }
    __device__ __forceinline__ void a_ready(const Unit&) const {}
    __device__ __forceinline__ void done(const Unit&) const {}
};


__device__ __forceinline__ unsigned cvt_pk_bf16(float lo, float hi) { unsigned r; asm volatile("v_cvt_pk_bf16_f32 %0, %1, %2" : "=v"(r) : "v"(lo), "v"(hi)); return r; }
typedef unsigned u32x2 __attribute__((ext_vector_type(2)));
#define PG8_EPI_BARRIER() do { asm volatile("s_waitcnt lgkmcnt(0)" ::: "memory"); __builtin_amdgcn_s_barrier(); asm volatile("" ::: "memory"); } while (0)
template <bool ROPE, bool PARTS> struct EpiQKVG {
    static constexpr bool PERM = true, AFTER_DRAIN = false;
    bf16_t* Q; bf16_t* K; bf16_t* V; bf16_t* G;
    const float* rstd;
    const float* qg; const float* kg; const float* rcos; const float* rsin;
    PG8_LAS float* P;
    __device__ __forceinline__ void operator()(f32x4 (&acc)[2][2][4][2], const Unit& u, int wr, int wc, int fr, int fq) const {
        const int sec = u.pn >> 3, hc = (u.pn & 7) * 256, rl0 = wr * 64 + fr;
#pragma unroll
        for (int ai = 0; ai < 2; ++ai)
#pragma unroll
            for (int m = 0; m < 4; ++m) { if (PARTS) { const int row = u.pm * BM + ai * HALF + rl0 + m * 16;
                const f32x4 a = *(const f32x4*)(rstd + (size_t)row * 8), b = *(const f32x4*)(rstd + (size_t)row * 8 + 4);
                const float rs = __builtin_amdgcn_rsqf(((a[0] + a[1]) + (a[2] + a[3]) + (b[0] + b[1]) + (b[2] + b[3])) * (1.0f / 2048.f) + 1e-6f);
#pragma unroll
                for (int bj = 0; bj < 2; ++bj)
#pragma unroll
                    for (int n = 0; n < 2; ++n) acc[ai][bj][m][n] = acc[ai][bj][m][n] * rs; } }
        if (sec <= 1) {
#pragma unroll
            for (int ai = 0; ai < 2; ++ai)
#pragma unroll
                for (int m = 0; m < 4; ++m) { const int rloc = ai * HALF + rl0 + m * 16;
#pragma unroll
                    for (int bj = 0; bj < 2; ++bj) { const f32x4 a = acc[ai][bj][m][0], b = acc[ai][bj][m][1];
                        float ss = (a[0] * a[0] + a[1] * a[1]) + (a[2] * a[2] + a[3] * a[3]) + (b[0] * b[0] + b[1] * b[1]) + (b[2] * b[2] + b[3] * b[3]);
                        ss += __shfl_xor(ss, 16); ss += __shfl_xor(ss, 32);
                        if (fq == 0) P[rloc * 8 + bj * 4 + wc] = ss; } }
            PG8_EPI_BARRIER();
            const float* gn = (sec == 0 ? qg : kg) + wc * 32 + 8 * fq;
            const f32x4 g0 = *(const f32x4*)gn, g1 = *(const f32x4*)(gn + 4);
            bf16_t* dst = sec == 0 ? Q : K;
#pragma unroll
            for (int ai = 0; ai < 2; ++ai)
#pragma unroll
                for (int m = 0; m < 4; ++m) { const int rloc = ai * HALF + rl0 + m * 16, row = u.pm * BM + rloc;
                    f32x4 c0, c1, s0, s1;
                    if (ROPE && wc == 0) { const float* cp = rcos + (size_t)row * 16 + 8 * (fq & 1); const float* sp = rsin + (size_t)row * 16 + 8 * (fq & 1);
                        c0 = *(const f32x4*)cp; c1 = *(const f32x4*)(cp + 4); s0 = *(const f32x4*)sp; s1 = *(const f32x4*)(sp + 4);
                        if (fq < 2) { s0 = -s0; s1 = -s1; } }
#pragma unroll
                    for (int bj = 0; bj < 2; ++bj) { const f32x4 p4 = *(const PG8_LAS f32x4*)(P + rloc * 8 + bj * 4);
                        const float rh = __builtin_amdgcn_rsqf(((p4[0] + p4[1]) + (p4[2] + p4[3])) * (1.0f / 128.f) + 1e-6f);
                        f32x4 v0 = acc[ai][bj][m][0] * rh * g0, v1 = acc[ai][bj][m][1] * rh * g1;
                        if (ROPE && wc == 0) {
#pragma unroll
                            for (int j = 0; j < 4; ++j) { const float p0 = __shfl_xor(v0[j], 32), p1 = __shfl_xor(v1[j], 32);
                                v0[j] = v0[j] * c0[j] + p0 * s0[j]; v1[j] = v1[j] * c1[j] + p1 * s1[j]; } }
                        u32x4 w; w.x = cvt_pk_bf16(v0[0], v0[1]); w.y = cvt_pk_bf16(v0[2], v0[3]); w.z = cvt_pk_bf16(v1[0], v1[1]); w.w = cvt_pk_bf16(v1[2], v1[3]);
                        *(u32x4*)(dst + (size_t)row * 2048 + hc + bj * HALF + wc * 32 + 8 * fq) = w; } }
        } else {
            bf16_t* dst = sec == 2 ? V : G;
#pragma unroll
            for (int ai = 0; ai < 2; ++ai)
#pragma unroll
                for (int m = 0; m < 4; ++m) { const int row = u.pm * BM + ai * HALF + rl0 + m * 16;
#pragma unroll
                    for (int bj = 0; bj < 2; ++bj) { f32x4 v0 = acc[ai][bj][m][0], v1 = acc[ai][bj][m][1];
                        if (sec == 3) {
#pragma unroll
                            for (int j = 0; j < 4; ++j) { v0[j] = v0[j] * __builtin_amdgcn_rcpf(1.0f + __builtin_amdgcn_exp2f(-1.4426950408889634f * v0[j]));
                                                          v1[j] = v1[j] * __builtin_amdgcn_rcpf(1.0f + __builtin_amdgcn_exp2f(-1.4426950408889634f * v1[j])); } }
                        u32x4 w; w.x = cvt_pk_bf16(v0[0], v0[1]); w.y = cvt_pk_bf16(v0[2], v0[3]); w.z = cvt_pk_bf16(v1[0], v1[1]); w.w = cvt_pk_bf16(v1[2], v1[3]);
                        *(u32x4*)(dst + (size_t)row * 2048 + hc + bj * HALF + wc * 32 + 8 * fq) = w; } }
        }
    }
};

struct EpiNull { static constexpr bool PERM = true, AFTER_DRAIN = false;
    __device__ __forceinline__ void operator()(f32x4 (&acc)[2][2][4][2], const Unit&, int, int, int, int) const {
#pragma unroll
        for (int ai = 0; ai < 2; ++ai)
#pragma unroll
            for (int bj = 0; bj < 2; ++bj)
#pragma unroll
                for (int m = 0; m < 4; ++m)
#pragma unroll
                    for (int n = 0; n < 2; ++n) asm volatile("" :: "v"(acc[ai][bj][m][n])); } };
struct EpiResMid {
    static constexpr bool PERM = false, AFTER_DRAIN = false;
    const float* resid; bf16_t* xb; float* ssqp; PG8_LAS float* P;
    __device__ __forceinline__ void operator()(f32x4 (&acc)[2][2][4][2], const Unit& u, int wr, int wc, int fr, int fq) const {
        const int col0 = u.pn * BM + wc * 32 + 4 * fq, rl0 = wr * 64 + fr;
#pragma unroll
        for (int ai = 0; ai < 2; ++ai)
#pragma unroll
            for (int m = 0; m < 4; ++m) { const int rloc = ai * HALF + rl0 + m * 16; const size_t off = (size_t)(u.pm * BM + rloc) * 2048 + col0; float ss = 0.f;
#pragma unroll
                for (int bj = 0; bj < 2; ++bj)
#pragma unroll
                    for (int n = 0; n < 2; ++n) { const f32x4 r = *(const f32x4*)(resid + off + bj * HALF + n * 16); const f32x4 o = r + acc[ai][bj][m][n];
                        ss += (o[0] * o[0] + o[1] * o[1]) + (o[2] * o[2] + o[3] * o[3]);
                        u32x2 w; w.x = cvt_pk_bf16(o[0], o[1]); w.y = cvt_pk_bf16(o[2], o[3]); *(u32x2*)(xb + off + bj * HALF + n * 16) = w; }
                ss += __shfl_xor(ss, 16); ss += __shfl_xor(ss, 32); if (fq == 0) P[rloc * 4 + wc] = ss;
                if (m & 1) asm volatile("" ::: "memory"); }
        PG8_EPI_BARRIER();
        if (wc == 0 && fq == 0) {
#pragma unroll
            for (int ai = 0; ai < 2; ++ai)
#pragma unroll
                for (int m = 0; m < 4; ++m) { const int rloc = ai * HALF + rl0 + m * 16; const f32x4 p4 = *(const PG8_LAS f32x4*)(P + rloc * 4);
                    ssqp[(size_t)(u.pm * BM + rloc) * 8 + u.pn] = (p4[0] + p4[1]) + (p4[2] + p4[3]); } }
    }
};
struct EpiResOut {
    static constexpr bool PERM = false, AFTER_DRAIN = false;
    const bf16_t* xb; float* out;
    __device__ __forceinline__ void operator()(f32x4 (&acc)[2][2][4][2], const Unit& u, int wr, int wc, int fr, int fq) const {
        const int col0 = u.pn * BM + wc * 32 + 4 * fq, rl0 = wr * 64 + fr;
#pragma unroll
        for (int ai = 0; ai < 2; ++ai)
#pragma unroll
            for (int m = 0; m < 4; ++m) { const size_t off = (size_t)(u.pm * BM + ai * HALF + rl0 + m * 16) * 2048 + col0;
#pragma unroll
                for (int bj = 0; bj < 2; ++bj)
#pragma unroll
                    for (int n = 0; n < 2; ++n) { const u32x2 r = *(const u32x2*)(xb + off + bj * HALF + n * 16);
                        f32x4 o = acc[ai][bj][m][n]; o[0] += __uint_as_float(r.x << 16); o[1] += __uint_as_float(r.x & 0xffff0000u); o[2] += __uint_as_float(r.y << 16); o[3] += __uint_as_float(r.y & 0xffff0000u);
                        *(f32x4*)(out + off + bj * HALF + n * 16) = o; }
                if (m & 1) asm volatile("" ::: "memory"); }
    }
};

template <class Epi, class Sched, bool ALIGN_EPI = false, bool SP2 = false>
__device__ __forceinline__ void gemm_phase(PG8_LAS unsigned char* lds, const Gemm g, const Sched& S, const Epi& E, const int tid) {
    const int wid = __builtin_amdgcn_readfirstlane(tid >> 6), lane = tid & 63, wr = wid >> 2, wc = wid & 3, fr = lane & 15, fq = lane >> 4;
    const int K = g.K, nt = K / BK;
    unsigned voffA[2], voffB[2];
#pragma unroll
    for (int i = 0; i < 2; ++i) { int R, C; stage_rc(tid * 16 + i * 8192, R, C); const int Rb = Epi::PERM ? ((R & ~31) + perm32(R & 31)) : R;
        voffA[i] = (unsigned)(R * K + C) * 2u; voffB[i] = (unsigned)(Rb * K + C) * 2u; }
    const size_t kstep = (size_t)(BK * 2);
    const size_t hstep = (size_t)HALF * K * 2;
    const size_t tstep = 2 * hstep;
    const unsigned ldsw = (unsigned)wid * 1024u;
    const int aoff = lds_byte(wr * 64 + fr, fq * 8), boff = lds_byte(wc * 32 + fr, fq * 8);
#define PG8_SA(b, h) (((b) * 2 + (h)) * HTB)
#define PG8_SB(b, h) ((4 + (b) * 2 + (h)) * HTB)
#define PG8_STAGE(bufoff, gbase, voff) do { _Pragma("unroll") for (int _i = 0; _i < 2; ++_i) \
        __builtin_amdgcn_global_load_lds((const unsigned*)((const char*)(gbase) + (voff)[_i]), (PG8_LAS unsigned*)(lds + (bufoff) + ldsw + _i * 8192), 16, 0, 0); } while (0)
#define PG8_LDA(dst, b, h) do { _Pragma("unroll") for (int m = 0; m < 4; ++m) _Pragma("unroll") for (int k = 0; k < 2; ++k) dst[m][k] = *(const PG8_LAS bf16x8*)(lds + PG8_SA(b, h) + aoff + m * 2048 + k * 1024); } while (0)
#define PG8_LDB(dst, b, h) do { _Pragma("unroll") for (int n = 0; n < 2; ++n) _Pragma("unroll") for (int k = 0; k < 2; ++k) dst[n][k] = *(const PG8_LAS bf16x8*)(lds + PG8_SB(b, h) + boff + n * 2048 + k * 1024); } while (0)
#define PG8_MMA(ai, bj, At, Bt) do { __builtin_amdgcn_s_setprio(1); _Pragma("unroll") for (int m = 0; m < 4; ++m) _Pragma("unroll") for (int n = 0; n < 2; ++n) _Pragma("unroll") for (int k = 0; k < 2; ++k) \
        acc[ai][bj][m][n] = __builtin_amdgcn_mfma_f32_16x16x32_bf16(Bt[n][k], At[m][k], acc[ai][bj][m][n], 0, 0, 0); __builtin_amdgcn_s_setprio(0); } while (0)
#define PG8_WAIT_V(n) asm volatile("s_waitcnt vmcnt(" #n ")" ::: "memory")
#define PG8_WAIT_L(n) asm volatile("s_waitcnt lgkmcnt(" #n ")" ::: "memory")
#define PG8_BAR __builtin_amdgcn_s_barrier()
#define PG8_SCHED __builtin_amdgcn_sched_barrier(0)
    Unit cur, nxt; int ui = 0;
    if (!S.next(0, cur)) return;
    f32x4 acc[2][2][4][2];
#pragma unroll
    for (int a = 0; a < 2; ++a)
#pragma unroll
        for (int b = 0; b < 2; ++b)
#pragma unroll
            for (int m = 0; m < 4; ++m)
#pragma unroll
                for (int n = 0; n < 2; ++n) acc[a][b][m][n] = (f32x4){0.f, 0.f, 0.f, 0.f};
    bf16x8 At[4][2], B0[2][2], B1[2][2];
    const char* cA = (const char*)g.A + (size_t)cur.pm * tstep; const char* cB = (const char*)g.Bt + (size_t)cur.pn * tstep;
    S.a_ready(cur);
    if constexpr (SP2) {
        PG8_STAGE(PG8_SB(0, 0), cB, voffB); PG8_STAGE(PG8_SB(0, 1), cB + hstep, voffB); PG8_STAGE(PG8_SA(0, 0), cA, voffA); PG8_STAGE(PG8_SA(0, 1), cA + hstep, voffA);
        if (wr == 1) PG8_BAR;
        PG8_WAIT_V(2); PG8_BAR;
        PG8_STAGE(PG8_SB(1, 0), cB + kstep, voffB); PG8_STAGE(PG8_SA(1, 0), cA + kstep, voffA); PG8_STAGE(PG8_SB(1, 1), cB + hstep + kstep, voffB);
        PG8_WAIT_V(6); PG8_BAR;
    } else {
        PG8_STAGE(PG8_SB(0, 0), cB, voffB); PG8_STAGE(PG8_SA(0, 0), cA, voffA); PG8_STAGE(PG8_SB(0, 1), cB + hstep, voffB); PG8_STAGE(PG8_SA(0, 1), cA + hstep, voffA);
        if (wr == 1) PG8_BAR;
        PG8_WAIT_V(4); PG8_BAR;
        PG8_STAGE(PG8_SB(1, 0), cB + kstep, voffB); PG8_STAGE(PG8_SA(1, 0), cA + kstep, voffA); PG8_STAGE(PG8_SB(1, 1), cB + hstep + kstep, voffB);
        PG8_WAIT_V(6); PG8_BAR;
    }
    for (;;) {
        const bool has_next = S.next(ui + 1, nxt);
        const char* nA = has_next ? (const char*)g.A + (size_t)nxt.pm * tstep : cA; const char* nB = has_next ? (const char*)g.Bt + (size_t)nxt.pn * tstep : cB;
        for (int t = 0; t < nt; t += 2) {
            const bool last = (t == nt - 2);
            const char* a1 = cA + (size_t)(t + 1) * kstep;
            const char* a2 = last ? nA : cA + (size_t)(t + 2) * kstep; const char* b2 = last ? nB : cB + (size_t)(t + 2) * kstep;
            const char* a3 = a2 + kstep; const char* b3 = b2 + kstep;
            if (last && has_next) S.a_ready(nxt);
            if constexpr (SP2) {
            PG8_LDB(B0, 0, 0); PG8_LDB(B1, 0, 1); PG8_SCHED; PG8_LDA(At, 0, 0); PG8_STAGE(PG8_SA(1, 1), a1 + hstep, voffA);
            PG8_WAIT_V(8); PG8_WAIT_L(0); PG8_BAR; PG8_MMA(0, 0, At, B0); PG8_MMA(0, 1, At, B1); PG8_BAR; PG8_SCHED;
            PG8_LDA(At, 0, 1); PG8_STAGE(PG8_SB(0, 0), b2, voffB); PG8_STAGE(PG8_SB(0, 1), b2 + hstep, voffB); PG8_STAGE(PG8_SA(0, 0), a2, voffA);
            PG8_WAIT_V(8); PG8_WAIT_L(0); PG8_BAR; PG8_MMA(1, 0, At, B0); PG8_MMA(1, 1, At, B1); PG8_BAR; PG8_SCHED;
            PG8_LDB(B0, 1, 0); PG8_LDB(B1, 1, 1); PG8_SCHED; PG8_LDA(At, 1, 0); PG8_STAGE(PG8_SA(0, 1), a2 + hstep, voffA);
            PG8_WAIT_V(8); PG8_WAIT_L(0); PG8_BAR; PG8_MMA(0, 0, At, B0); PG8_MMA(0, 1, At, B1); PG8_BAR; PG8_SCHED;
            PG8_LDA(At, 1, 1); PG8_STAGE(PG8_SB(1, 0), b3, voffB); PG8_STAGE(PG8_SB(1, 1), b3 + hstep, voffB); PG8_STAGE(PG8_SA(1, 0), a3, voffA);
            PG8_WAIT_V(8); PG8_WAIT_L(0); PG8_BAR; PG8_MMA(1, 0, At, B0); PG8_MMA(1, 1, At, B1); PG8_BAR; PG8_SCHED;
            } else {
            PG8_LDB(B0, 0, 0); PG8_SCHED; PG8_LDA(At, 0, 0); PG8_STAGE(PG8_SA(1, 1), a1 + hstep, voffA);
            PG8_WAIT_L(8); PG8_BAR; PG8_WAIT_L(0); PG8_MMA(0, 0, At, B0); PG8_BAR; PG8_SCHED;
            PG8_LDB(B1, 0, 1); PG8_STAGE(PG8_SB(0, 0), b2, voffB);
            PG8_BAR; PG8_WAIT_L(0); PG8_MMA(0, 1, At, B1); PG8_BAR;
            PG8_LDA(At, 0, 1); PG8_STAGE(PG8_SA(0, 0), a2, voffA);
            PG8_BAR; PG8_WAIT_L(0); PG8_MMA(1, 0, At, B0); PG8_BAR; PG8_SCHED;
            PG8_STAGE(PG8_SB(0, 1), b2 + hstep, voffB);
            PG8_WAIT_V(6); PG8_BAR; PG8_MMA(1, 1, At, B1); PG8_BAR;
            PG8_LDB(B0, 1, 0); PG8_SCHED; PG8_LDA(At, 1, 0); PG8_STAGE(PG8_SA(0, 1), a2 + hstep, voffA);
            PG8_WAIT_L(8); PG8_BAR; PG8_WAIT_L(0); PG8_MMA(0, 0, At, B0); PG8_BAR; PG8_SCHED;
            PG8_LDB(B1, 1, 1); PG8_STAGE(PG8_SB(1, 0), b3, voffB);
            PG8_BAR; PG8_WAIT_L(0); PG8_MMA(0, 1, At, B1); PG8_BAR;
            PG8_LDA(At, 1, 1); PG8_STAGE(PG8_SA(1, 0), a3, voffA);
            PG8_BAR; PG8_WAIT_L(0); PG8_MMA(1, 0, At, B0); PG8_BAR; PG8_SCHED;
            PG8_STAGE(PG8_SB(1, 1), b3 + hstep, voffB);
            PG8_WAIT_V(6); PG8_BAR; PG8_MMA(1, 1, At, B1); PG8_BAR;
            }
        }
        if constexpr (ALIGN_EPI) { if (wr == 0) PG8_BAR; }
        if constexpr (!Epi::AFTER_DRAIN) { E(acc, cur, wr, wc, fr, fq); S.done(cur); }
        if (!has_next) break;
#pragma unroll
        for (int a = 0; a < 2; ++a)
#pragma unroll
            for (int b = 0; b < 2; ++b)
#pragma unroll
                for (int m = 0; m < 4; ++m)
#pragma unroll
                    for (int n = 0; n < 2; ++n) acc[a][b][m][n] = (f32x4){0.f, 0.f, 0.f, 0.f};
        cur = nxt; cA = nA; cB = nB; ++ui;
        if constexpr (ALIGN_EPI) { if (wr == 1) PG8_BAR; }
    }
    PG8_WAIT_V(0);
    if constexpr (!ALIGN_EPI) { if (wr == 0) PG8_BAR; }
    PG8_BAR;
    if constexpr (Epi::AFTER_DRAIN) { E.fused(acc, cur, wr, wc, fr, fq, lds, wid, lane); S.done(cur); }
#undef PG8_SA
#undef PG8_SB
#undef PG8_STAGE
#undef PG8_LDA
#undef PG8_LDB
#undef PG8_MMA
#undef PG8_WAIT_V
#undef PG8_WAIT_L
#undef PG8_BAR
#undef PG8_SCHED
}
}

namespace cg = cooperative_groups;
#ifndef WGM_BIG
#define WGM_BIG 4
#endif
#ifndef WGM_SMALL
#define WGM_SMALL 4
#endif
static_assert(8 % WGM_BIG == 0 && 8 % WGM_SMALL == 0, "the group barriers need every batch's 8 row tiles inside one XCD-chunk of the GEMM tile order: the group size must divide 8");
#ifndef PG8_SP2
#define PG8_SP2 true
#endif
#define LAS __attribute__((address_space(3)))
constexpr int NWAVES = 8, NTHREADS = NWAVES * 64;
constexpr int RING_BYTES = 131072;
constexpr int EPI_OFF = RING_BYTES;
constexpr int LDS_BYTES = 147456;
constexpr size_t WS_SSQP = 5 * MiB;

__device__ __forceinline__ int lane_id_v() { int l; asm volatile("v_mbcnt_lo_u32_b32 %0, -1, 0\n\tv_mbcnt_hi_u32_b32 %0, -1, %0" : "=v"(l)); return l; }
__device__ __forceinline__ int make_tid(const int wave_s) { return wave_s * 64 + lane_id_v(); }
namespace att {
typedef short s16x4 __attribute__((ext_vector_type(4)));
typedef float f32x16 __attribute__((ext_vector_type(16)));
typedef unsigned u32x4 __attribute__((ext_vector_type(4)));
constexpr int D = 128, PITCH = 2048, NW = 8, QBLK = 32, KVBLK = 64, QB = NW * QBLK;
constexpr int SHM_V = KVBLK * D * 2, SHM_K = KVBLK * D * 2;
constexpr int OFF_WS = 2 * SHM_V + 2 * SHM_K;
constexpr int OFF_BIAS = OFF_WS + NW * 64 * 4;
constexpr int OFF_SSQ = OFF_BIAS + 2048 * 4;
constexpr int OFF_STG = OFF_SSQ + NW * 32 * 4 + 256;
constexpr int LDS_END = OFF_STG + NW * 8192;
static_assert(OFF_STG % 16 == 0 && LDS_END <= LDS_BYTES, "attention LDS map");
constexpr float SCALE = 0.08838834764831845f, THR = 8.f;
#define KSWZ(row, colB) ((row) * 256 + ((colB) ^ (((row) & 15) << 4)))
#define SBAR() __builtin_amdgcn_sched_barrier(0)
__device__ __forceinline__ int v_st(int k, int c) { const int kk = (k & ~0xC) | ((k & 4) << 1) | ((k & 8) >> 1); return ((kk >> 3) * 4 + (c >> 5)) * 512 + ((kk & 7) * 32 + (c & 31)) * 2; }
__device__ __forceinline__ int v_rd_base(int lane) { return ((lane & 3) << 3) | (((lane >> 2) & 3) << 6) | (((lane >> 4) & 1) << 5) | (((lane >> 5) & 1) << 8); }
constexpr int v_rd_off(int d0, int ks, int half) { return d0 * 512 + ks * 4096 + half * 2048; }
__device__ __forceinline__ int crow(int r, int hi) { return (r & 3) + 8 * (r >> 2) + 4 * hi; }
__device__ __forceinline__ unsigned cvtpk(float lo, float hi) { unsigned r; asm volatile("v_cvt_pk_bf16_f32 %0, %1, %2" : "=v"(r) : "v"(lo), "v"(hi)); return r; }
__device__ __forceinline__ void mask_tile(f32x16& p0, f32x16& p1, int dq) {
    const float NEG = -__builtin_inff();
#pragma unroll
    for (int r = 0; r < 16; ++r) { const int c = (r & 3) + 8 * (r >> 2); if (dq - c < 0) p0[r] = NEG; if (dq - c - 32 < 0) p1[r] = NEG; }
}
__device__ __forceinline__ void partialSM(f32x16& p0, f32x16& p1, float& m_reg, float& mn, float& alpha) {
    float pmax = p0[0]; for (int r = 1; r < 16; ++r) pmax = fmaxf(pmax, p0[r]); for (int r = 0; r < 16; ++r) pmax = fmaxf(pmax, p1[r]);
    { auto rr = __builtin_amdgcn_permlane32_swap(__float_as_uint(pmax), __float_as_uint(pmax), false, false);
      pmax = fmaxf(__uint_as_float(rr[0]), __uint_as_float(rr[1])); }
    constexpr float C2 = 1.4426950408889634f * SCALE;
    if (__builtin_expect(__all((pmax - m_reg) * SCALE <= THR), 1)) { mn = m_reg; alpha = 1.f; }
    else { mn = fmaxf(m_reg, pmax); alpha = __builtin_amdgcn_exp2f((m_reg - mn) * C2); m_reg = mn; }
    const float mnL = -mn * C2;
    for (int r = 0; r < 16; ++r) p0[r] = fmaf(p0[r], C2, mnL); for (int r = 0; r < 16; ++r) p1[r] = fmaf(p1[r], C2, mnL);
    for (int r = 0; r < 16; ++r) p0[r] = __builtin_amdgcn_exp2f(p0[r]);
}
__device__ __forceinline__ void finishSM(f32x16& p0, f32x16& p1, float alpha, float& l_reg, bf16x8& pa0, bf16x8& pa1, bf16x8& pa2, bf16x8& pa3) {
    for (int r = 0; r < 16; ++r) p1[r] = __builtin_amdgcn_exp2f(p1[r]);
    float ps = 0; for (int r = 0; r < 16; ++r) ps += p0[r]; for (int r = 0; r < 16; ++r) ps += p1[r];
    { auto rr = __builtin_amdgcn_permlane32_swap(__float_as_uint(ps), __float_as_uint(ps), false, false);
      ps = __uint_as_float(rr[0]) + __uint_as_float(rr[1]); }
    l_reg = l_reg * alpha + ps;
#define PK4(P, B_, OUT) do { unsigned a0 = cvtpk(P[B_+0], P[B_+1]), a1 = cvtpk(P[B_+2], P[B_+3]);                          \
        unsigned b0 = cvtpk(P[B_+4], P[B_+5]), b1 = cvtpk(P[B_+6], P[B_+7]);                                             \
        auto r0 = __builtin_amdgcn_permlane32_swap(a0, b0, false, false); auto r1 = __builtin_amdgcn_permlane32_swap(a1, b1, false, false); \
        u32x4 w = {r0[0], r1[0], r0[1], r1[1]}; OUT = *reinterpret_cast<bf16x8*>(&w); } while (0)
    PK4(p0, 0, pa0); PK4(p0, 8, pa1); PK4(p1, 0, pa2); PK4(p1, 8, pa3);
#undef PK4
}
template <int KB, bool BIAS, bool NOLDS = false>
__device__ __forceinline__ void qkt(f32x16& p0, f32x16& p1, const char* K_lds, int r32, int hi, const bf16x8* qr, const float* bptr) {
    if constexpr (BIAS) {
#pragma unroll
        for (int g = 0; g < 4; ++g) { const f32x4 a = *(const f32x4*)(bptr + 8 * g), b = *(const f32x4*)(bptr + 32 + 8 * g);
            p0[4 * g] = a[0]; p0[4 * g + 1] = a[1]; p0[4 * g + 2] = a[2]; p0[4 * g + 3] = a[3]; p1[4 * g] = b[0]; p1[4 * g + 1] = b[1]; p1[4 * g + 2] = b[2]; p1[4 * g + 3] = b[3]; }
    } else { p0 = f32x16{}; p1 = f32x16{}; }
#pragma unroll
    for (int d0 = 0; d0 < 8; ++d0) { const char* a = K_lds + KB * SHM_K + KSWZ(r32, (d0 * 16 + hi * 8) * 2);
        bf16x8 b0, b1;
        if constexpr (NOLDS) { b0 = qr[(d0 + 1) & 7]; b1 = qr[(d0 + 2) & 7]; } else { b0 = *reinterpret_cast<const bf16x8*>(a); b1 = *reinterpret_cast<const bf16x8*>(a + 32 * 256); }
        p0 = __builtin_amdgcn_mfma_f32_32x32x16_bf16(b0, qr[d0], p0, 0, 0, 0);
        p1 = __builtin_amdgcn_mfma_f32_32x32x16_bf16(b1, qr[d0], p1, 0, 0, 0); }
}
template <int VB, bool NOLDS = false>
__device__ __forceinline__ void pv_tile(f32x16* o, int vb0, bf16x8 pa0, bf16x8 pa1, bf16x8 pa2, bf16x8 pa3) {
    if constexpr (NOLDS) {
#pragma unroll
        for (int d0 = 0; d0 < 4; ++d0) { o[d0] = __builtin_amdgcn_mfma_f32_32x32x16_bf16(pa0, pa1, o[d0], 0, 0, 0); o[d0] = __builtin_amdgcn_mfma_f32_32x32x16_bf16(pa1, pa2, o[d0], 0, 0, 0);
            o[d0] = __builtin_amdgcn_mfma_f32_32x32x16_bf16(pa2, pa3, o[d0], 0, 0, 0); o[d0] = __builtin_amdgcn_mfma_f32_32x32x16_bf16(pa3, pa0, o[d0], 0, 0, 0); }
        return; }
#define TRRD(dst, off) asm volatile("ds_read_b64_tr_b16 %0, %1 offset:%2" : "=&v"(dst) : "v"(vb0), "i"(off) : "memory")
#define PV_D0(d0) do { s16x4 l0, l1, l2, l3, h0, h1, h2, h3; constexpr int b_ = VB * SHM_V + v_rd_off(d0, 0, 0); \
        TRRD(l0, b_); TRRD(h0, b_ + 2048); TRRD(l1, b_ + 4096); TRRD(h1, b_ + 6144); TRRD(l2, b_ + 8192); TRRD(h2, b_ + 10240); TRRD(l3, b_ + 12288); TRRD(h3, b_ + 14336); \
        asm volatile("s_waitcnt lgkmcnt(0)" ::: "memory"); SBAR();   \
        o[d0] = __builtin_amdgcn_mfma_f32_32x32x16_bf16(pa0, (bf16x8){l0[0], l0[1], l0[2], l0[3], h0[0], h0[1], h0[2], h0[3]}, o[d0], 0, 0, 0);   \
        o[d0] = __builtin_amdgcn_mfma_f32_32x32x16_bf16(pa1, (bf16x8){l1[0], l1[1], l1[2], l1[3], h1[0], h1[1], h1[2], h1[3]}, o[d0], 0, 0, 0);   \
        o[d0] = __builtin_amdgcn_mfma_f32_32x32x16_bf16(pa2, (bf16x8){l2[0], l2[1], l2[2], l2[3], h2[0], h2[1], h2[2], h2[3]}, o[d0], 0, 0, 0);   \
        o[d0] = __builtin_amdgcn_mfma_f32_32x32x16_bf16(pa3, (bf16x8){l3[0], l3[1], l3[2], l3[3], h3[0], h3[1], h3[2], h3[3]}, o[d0], 0, 0, 0); } while (0)
    PV_D0(0); PV_D0(1); PV_D0(2); PV_D0(3);
#undef PV_D0
#undef TRRD
}
template <int VB>
__device__ __forceinline__ void pv_sm(f32x16* o, int vb0, bf16x8 pa0, bf16x8 pa1, bf16x8 pa2, bf16x8 pa3, f32x16& x0, f32x16& x1, float& m_reg, float& mn, float& alpha) {
    constexpr float C2 = 1.4426950408889634f * SCALE;
    float pmax, mnL;
#define TRRD(dst, off) asm volatile("ds_read_b64_tr_b16 %0, %1 offset:%2" : "=&v"(dst) : "v"(vb0), "i"(off) : "memory")
#define PV_RD(d0) s16x4 l0, l1, l2, l3, h0, h1, h2, h3; { constexpr int b_ = VB * SHM_V + v_rd_off(d0, 0, 0); \
        TRRD(l0, b_); TRRD(h0, b_ + 2048); TRRD(l1, b_ + 4096); TRRD(h1, b_ + 6144); TRRD(l2, b_ + 8192); TRRD(h2, b_ + 10240); TRRD(l3, b_ + 12288); TRRD(h3, b_ + 14336); } SBAR()
#define PV_MM(d0) SBAR(); asm volatile("s_waitcnt lgkmcnt(0)" ::: "memory"); SBAR();   \
        o[d0] = __builtin_amdgcn_mfma_f32_32x32x16_bf16(pa0, (bf16x8){l0[0], l0[1], l0[2], l0[3], h0[0], h0[1], h0[2], h0[3]}, o[d0], 0, 0, 0);   \
        o[d0] = __builtin_amdgcn_mfma_f32_32x32x16_bf16(pa1, (bf16x8){l1[0], l1[1], l1[2], l1[3], h1[0], h1[1], h1[2], h1[3]}, o[d0], 0, 0, 0);   \
        o[d0] = __builtin_amdgcn_mfma_f32_32x32x16_bf16(pa2, (bf16x8){l2[0], l2[1], l2[2], l2[3], h2[0], h2[1], h2[2], h2[3]}, o[d0], 0, 0, 0);   \
        o[d0] = __builtin_amdgcn_mfma_f32_32x32x16_bf16(pa3, (bf16x8){l3[0], l3[1], l3[2], l3[3], h3[0], h3[1], h3[2], h3[3]}, o[d0], 0, 0, 0)
    { PV_RD(0);
      pmax = x0[0]; for (int r = 1; r < 16; ++r) pmax = fmaxf(pmax, x0[r]);
      PV_MM(0); }
    { PV_RD(1);
      for (int r = 0; r < 16; ++r) pmax = fmaxf(pmax, x1[r]);
      { auto rr = __builtin_amdgcn_permlane32_swap(__float_as_uint(pmax), __float_as_uint(pmax), false, false); pmax = fmaxf(__uint_as_float(rr[0]), __uint_as_float(rr[1])); }
      const bool keep = __all((pmax - m_reg) * SCALE <= THR);
      mn = keep ? m_reg : fmaxf(m_reg, pmax); alpha = keep ? 1.f : __builtin_amdgcn_exp2f((m_reg - mn) * C2); m_reg = mn; mnL = -mn * C2;
      PV_MM(1); }
    { PV_RD(2);
      for (int r = 0; r < 16; ++r) x0[r] = fmaf(x0[r], C2, mnL); for (int r = 0; r < 16; ++r) x1[r] = fmaf(x1[r], C2, mnL);
      PV_MM(2); }
    { PV_RD(3);
      for (int r = 0; r < 16; ++r) x0[r] = __builtin_amdgcn_exp2f(x0[r]);
      PV_MM(3); }
#undef PV_RD
#undef PV_MM
#undef TRRD
}
__device__ __forceinline__ void psm_fix(f32x16& p0, f32x16& p1, float mnL) {
    constexpr float C2 = 1.4426950408889634f * SCALE;
    for (int r = 0; r < 16; ++r) p0[r] = fmaf(p0[r], C2, mnL); for (int r = 0; r < 16; ++r) p1[r] = fmaf(p1[r], C2, mnL);
    for (int r = 0; r < 16; ++r) p0[r] = __builtin_amdgcn_exp2f(p0[r]);
}
__device__ __forceinline__ void fsm_fix(f32x16& p0, f32x16& p1, bf16x8& pa0, bf16x8& pa1, bf16x8& pa2, bf16x8& pa3) {
    for (int r = 0; r < 16; ++r) p1[r] = __builtin_amdgcn_exp2f(p1[r]);
#define PK4(P, B_, OUT) do { unsigned a0 = cvtpk(P[B_+0], P[B_+1]), a1 = cvtpk(P[B_+2], P[B_+3]);                          \
        unsigned b0 = cvtpk(P[B_+4], P[B_+5]), b1 = cvtpk(P[B_+6], P[B_+7]);                                             \
        auto r0 = __builtin_amdgcn_permlane32_swap(a0, b0, false, false); auto r1 = __builtin_amdgcn_permlane32_swap(a1, b1, false, false); \
        u32x4 w = {r0[0], r1[0], r0[1], r1[1]}; OUT = *reinterpret_cast<bf16x8*>(&w); } while (0)
    PK4(p0, 0, pa0); PK4(p0, 8, pa1); PK4(p1, 0, pa2); PK4(p1, 8, pa3);
#undef PK4
}
template <int VB>
__device__ __forceinline__ void pv_smf(f32x16* o, int vb0, bf16x8 pa0, bf16x8 pa1, bf16x8 pa2, bf16x8 pa3, f32x16& x0, f32x16& x1, float mnL) {
    constexpr float C2 = 1.4426950408889634f * SCALE;
#define TRRD(dst, off) asm volatile("ds_read_b64_tr_b16 %0, %1 offset:%2" : "=&v"(dst) : "v"(vb0), "i"(off) : "memory")
#define PV_RD(d0) s16x4 l0, l1, l2, l3, h0, h1, h2, h3; { constexpr int b_ = VB * SHM_V + v_rd_off(d0, 0, 0); \
        TRRD(l0, b_); TRRD(h0, b_ + 2048); TRRD(l1, b_ + 4096); TRRD(h1, b_ + 6144); TRRD(l2, b_ + 8192); TRRD(h2, b_ + 10240); TRRD(l3, b_ + 12288); TRRD(h3, b_ + 14336); } SBAR()
#define PV_MM(d0) SBAR(); asm volatile("s_waitcnt lgkmcnt(0)" ::: "memory"); SBAR();   \
        o[d0] = __builtin_amdgcn_mfma_f32_32x32x16_bf16(pa0, (bf16x8){l0[0], l0[1], l0[2], l0[3], h0[0], h0[1], h0[2], h0[3]}, o[d0], 0, 0, 0);   \
        o[d0] = __builtin_amdgcn_mfma_f32_32x32x16_bf16(pa1, (bf16x8){l1[0], l1[1], l1[2], l1[3], h1[0], h1[1], h1[2], h1[3]}, o[d0], 0, 0, 0);   \
        o[d0] = __builtin_amdgcn_mfma_f32_32x32x16_bf16(pa2, (bf16x8){l2[0], l2[1], l2[2], l2[3], h2[0], h2[1], h2[2], h2[3]}, o[d0], 0, 0, 0);   \
        o[d0] = __builtin_amdgcn_mfma_f32_32x32x16_bf16(pa3, (bf16x8){l3[0], l3[1], l3[2], l3[3], h3[0], h3[1], h3[2], h3[3]}, o[d0], 0, 0, 0)
    { PV_RD(0); for (int r = 0; r < 16; ++r) x0[r] = fmaf(x0[r], C2, mnL); PV_MM(0); }
    { PV_RD(1); for (int r = 0; r < 16; ++r) x1[r] = fmaf(x1[r], C2, mnL); PV_MM(1); }
    { PV_RD(2); for (int r = 0; r < 8; ++r) x0[r] = __builtin_amdgcn_exp2f(x0[r]); PV_MM(2); }
    { PV_RD(3); for (int r = 8; r < 16; ++r) x0[r] = __builtin_amdgcn_exp2f(x0[r]); PV_MM(3); }
#undef PV_RD
#undef PV_MM
#undef TRRD
}
struct BlockRef { const bf16_t* Q; const bf16_t* K; const bf16_t* V; int P0; int row0; int head; int step; int jlo; };
struct Seam { bf16x8 qr[8]; bf16x8 st_v0, st_v1, st_k0, st_k1; };
#define ROW(p, k0, rr) ((p) + (size_t)((k0) + (rr)) * PITCH + sc)
#define VMW() asm volatile("s_waitcnt vmcnt(0)" ::: "memory")
#define VMWN(n) asm volatile("s_waitcnt vmcnt(%0)" :: "i"(n) : "memory")
#define SLOAD_H(Kp, Vp, k0) do { S.st_v0 = *(const bf16x8*)ROW(Vp, k0, sr); S.st_v1 = *(const bf16x8*)ROW(Vp, k0, 32 + sr);              \
                         S.st_k0 = *(const bf16x8*)ROW(Kp, k0, sr); S.st_k1 = *(const bf16x8*)ROW(Kp, k0, 32 + sr); } while (0)
#define SWRITE_HK(bf) do { *(bf16x8*)(K_lds + (bf) * SHM_K + kws) = S.st_k0; *(bf16x8*)(K_lds + (bf) * SHM_K + kws + 32 * 256) = S.st_k1; } while (0)
#define SWRITE_HV(bf) do { *(bf16x8*)(V_lds + (bf) * SHM_V + vst0) = S.st_v0; *(bf16x8*)(V_lds + (bf) * SHM_V + vst1) = S.st_v1; } while (0)
#define SWRITE_H(bf) do { SWRITE_HV(bf); SWRITE_HK(bf); } while (0)
template <int MODE>
__device__ __forceinline__ void attn_prime(const BlockRef& cur, char* lds, Seam& S, const int wave_s) {
    const int tid = make_tid(wave_s); const int wid = __builtin_amdgcn_readfirstlane(tid >> 6), lane = tid & 63, r32 = lane & 31, hi = lane >> 5;
    const int sr = tid >> 4, sc = (tid & 15) * 8, kws = KSWZ(sr, sc * 2); char* K_lds = lds + 2 * SHM_V;
    for (int d0 = 0; d0 < 8; ++d0) S.qr[d0] = *(const bf16x8*)(cur.Q + (size_t)(wid * QBLK + r32) * PITCH + d0 * 16 + hi * 8);
    SLOAD_H(cur.K, cur.V, (MODE == 1 ? cur.P0 + 3 * KVBLK : 0)); VMW(); SWRITE_HK(0);
    __syncthreads();
}
template <int MODE, class Epi, bool FIXM = false>
__device__ __forceinline__ void attn_block(const BlockRef& cur, const BlockRef& nxt, char* lds, Seam& S, const Epi& epi, const int wave_s) {
    constexpr bool BIAS = MODE == 1;
    const int tid = make_tid(wave_s); const int wid = __builtin_amdgcn_readfirstlane(tid >> 6), lane = tid & 63, r32 = lane & 31, hi = lane >> 5;
    const int NTF = cur.P0 / KVBLK + 4, NT = NTF - (MODE == 1 ? cur.jlo : 0);
    const int qlo = cur.P0 + wid * QBLK;
    const int qlimw = MODE == 0 ? (qlo | 63) : qlo;
    const int qm = (MODE == 0 ? (qlo | 63) : qlo + r32) - 4 * hi;
    char* V_lds = lds; char* K_lds = lds + 2 * SHM_V;
    float* ws = (float*)(lds + OFF_WS) + wid * 64; float* li_l = ws, * al_l = ws + 32;
    const float* btab = (const float*)(lds + OFF_BIAS) + 4 * hi;
    float m_reg = -1e30f, l_reg = 0; f32x16 o[4] = {};
    float2* stat = (float2*)(lds + OFF_BIAS) + (wid * 2 + (cur.step & 1)) * 32;
    float mnLf = 0.f, mA_ = 0.f, alA_ = 1.f; (void)mnLf; (void)mA_; (void)alA_;
    if constexpr (FIXM) { const float2 ml = stat[r32]; m_reg = ml.x; l_reg = ml.y; mnLf = -ml.x * (1.4426950408889634f * SCALE); }
    const int sr = tid >> 4, sc = (tid & 15) * 8, vst0 = v_st(sr, sc), vst1 = v_st(32 + sr, sc), kws = KSWZ(sr, sc * 2);
    const int vb0 = (int)(uintptr_t)V_lds + v_rd_base(lane);
    const bf16_t* Kh = cur.K; const bf16_t* Vh = cur.V;
#define RESC(a) do { if constexpr (!FIXM) if (__any((a) < 1.f)) { if (hi == 0) al_l[r32] = (a); asm volatile("s_waitcnt lgkmcnt(0)" ::: "memory");              \
                     for (int d_ = 0; d_ < 4; ++d_) for (int r = 0; r < 16; ++r) o[d_][r] *= al_l[crow(r, hi)]; } } while (0)
#define KBASE(t) ((MODE == 1 ? NTF - 1 - (t) : (t)) * KVBLK)
#define MASKT(P0_, P1_, t) do { const int kb_ = KBASE(t); if (kb_ + KVBLK - 1 > qlimw) { asm volatile("; mask tile"); mask_tile(P0_, P1_, qm - kb_); } } while (0)
#define SEAM_K0() do { VMWN(8); SWRITE_HK(0); SBAR(); } while (0)
    f32x16 pA0, pA1, pB0, pB1; float mnA = 0.f, mnB = 0.f, alA = 1.f, alB = 1.f; bf16x8 pa0, pa1, pa2, pa3; (void)mnA; (void)mnB;
#define A_QKT(KB, X0, X1, t) qkt<KB, BIAS>(X0, X1, K_lds, r32, hi, S.qr, btab + KBASE(t))
#define A_PV(VB) pv_tile<VB>(o, vb0, pa0, pa1, pa2, pa3)
#define A_PSM(X0, X1, mnX, alX) do { if constexpr (FIXM) psm_fix(X0, X1, mnLf); else partialSM(X0, X1, m_reg, mnX, alX); } while (0)
#define A_FSM(Y0, Y1, alY) do { if constexpr (FIXM) fsm_fix(Y0, Y1, pa0, pa1, pa2, pa3); else finishSM(Y0, Y1, alY, l_reg, pa0, pa1, pa2, pa3); } while (0)
#define A_PVSM(VB, X0, X1, mnX, alX) do { if constexpr (FIXM) pv_smf<VB>(o, vb0, pa0, pa1, pa2, pa3, X0, X1, mnLf); else pv_sm<VB>(o, vb0, pa0, pa1, pa2, pa3, X0, X1, m_reg, mnX, alX); } while (0)
#define A_SLOAD(Kp, Vp, k0) SLOAD_H(Kp, Vp, k0)
#define A_SWRITE(bf) do { VMW(); SWRITE_H(bf); } while (0)
#define A_SYNC() __syncthreads()
    SWRITE_HV(0); SBAR();
    A_SLOAD(Kh, Vh, KBASE(1));
    SBAR(); A_QKT(0, pA0, pA1, 0);
    MASKT(pA0, pA1, 0); A_PSM(pA0, pA1, mnA, alA);
    A_SWRITE(1);
    A_SYNC();
#define HALF_STEP(PX0, PX1, mnX, alX, PY0, PY1, alY, t, KB, VB, SB) do {                                                      \
        SBAR(); A_QKT(KB, PX0, PX1, t);                                                                                      \
        A_FSM(PY0, PY1, alY); SBAR();                                                                                         \
        if ((t) + 1 < NT) { A_SLOAD(Kh, Vh, KBASE((t) + 1)); SBAR(); }                                                        \
        MASKT(PX0, PX1, (t)); A_PVSM(VB, PX0, PX1, mnX, alX);                                                                 \
        A_SYNC();                                                                                                             \
        if ((t) + 1 < NT) { A_SWRITE(SB); }                                                                                   \
        RESC(alX); A_SYNC(); } while (0)
    for (int t = 1; t + 1 < NT; t += 2) {
        HALF_STEP(pB0, pB1, mnB, alB, pA0, pA1, alA, t, 1, 0, 0);
        HALF_STEP(pA0, pA1, mnA, alA, pB0, pB1, alB, t + 1, 0, 1, 1);
    }
    SBAR(); A_QKT(1, pB0, pB1, NT - 1); SBAR();
    SLOAD_H(nxt.K, nxt.V, (MODE == 1 ? nxt.P0 + 3 * KVBLK : 0)); SBAR();
#pragma unroll
    for (int d0 = 0; d0 < 8; ++d0) S.qr[d0] = *(const bf16x8*)(nxt.Q + (size_t)(wid * QBLK + r32) * PITCH + d0 * 16 + hi * 8);
    SBAR();
    A_FSM(pA0, pA1, alA); SBAR();
    MASKT(pB0, pB1, NT - 1); A_PVSM(0, pB0, pB1, mnB, alB); __syncthreads(); RESC(alB);
    A_FSM(pB0, pB1, alB); SBAR(); A_PV(1);
    SBAR(); SEAM_K0();
    f32x16 tp[4]; int lane_e = lane; asm volatile("" : "+v"(lane_e));
    epi.prefetch(tp, cur, wid, lane_e);
    if constexpr (MODE == 0 && !FIXM) { if (hi == 0) stat[r32] = make_float2(m_reg, l_reg); }
    if (hi == 0) li_l[r32] = l_reg; asm volatile("s_waitcnt lgkmcnt(0)" ::: "memory");
#pragma unroll
    for (int r = 0; r < 16; ++r) { const float rl = __builtin_amdgcn_rcpf(li_l[crow(r, hi)]);
#pragma unroll
        for (int d0 = 0; d0 < 4; ++d0) o[d0][r] *= rl; }
    epi(o, tp, cur, lds, wid, lane_e);
    __syncthreads();
#undef A_QKT
#undef A_PV
#undef A_PVSM
#undef A_PSM
#undef A_FSM
#undef A_SLOAD
#undef A_SWRITE
#undef A_SYNC
#undef RESC
#undef KBASE
#undef MASKT
#undef SEAM_K0
#undef HALF_STEP
}

template <int MODE>
__device__ __forceinline__ void attn_prime2(const BlockRef& cur, char* lds, Seam& S, const int wave_s) {
    const int tid = make_tid(wave_s); const int wid = __builtin_amdgcn_readfirstlane(tid >> 6), lane = tid & 63, r32 = lane & 31, hi = lane >> 5;
    const int sr = tid >> 4, sc = (tid & 15) * 8, kws = KSWZ(sr, sc * 2); char* K_lds = lds + 2 * SHM_V;
    for (int d0 = 0; d0 < 8; ++d0) S.qr[d0] = *(const bf16x8*)(cur.Q + (size_t)(wid * QBLK + r32) * PITCH + d0 * 16 + hi * 8);
    const int kb0 = MODE == 1 ? cur.P0 + 3 * KVBLK : 0, kb1 = MODE == 1 ? cur.P0 + 2 * KVBLK : KVBLK;
    const bf16x8 ka = *(const bf16x8*)ROW(cur.K, kb0, sr), kb = *(const bf16x8*)ROW(cur.K, kb0, 32 + sr);
    S.st_k0 = *(const bf16x8*)ROW(cur.K, kb1, sr); S.st_k1 = *(const bf16x8*)ROW(cur.K, kb1, 32 + sr);
    S.st_v0 = *(const bf16x8*)ROW(cur.V, kb0, sr); S.st_v1 = *(const bf16x8*)ROW(cur.V, kb0, 32 + sr);
    *(bf16x8*)(K_lds + kws) = ka; *(bf16x8*)(K_lds + kws + 32 * 256) = kb;
    __syncthreads();
}
template <int MODE, class Epi, bool FIXM = false>
__device__ __forceinline__ void attn_block2(const BlockRef& cur, const BlockRef& nxt, char* lds, Seam& S, const Epi& epi, const int wave_s) {
    constexpr bool BIAS = MODE == 1;
    const int tid = make_tid(wave_s); const int wid = __builtin_amdgcn_readfirstlane(tid >> 6), lane = tid & 63, r32 = lane & 31, hi = lane >> 5;
    const int grp = wave_s >> 2;
    const int NTF = cur.P0 / KVBLK + 4, NT = NTF - (MODE == 1 ? cur.jlo : 0);
    const int NTFn = nxt.P0 / KVBLK + 4;
    const int qlo = cur.P0 + wid * QBLK;
    const int qlimw = MODE == 0 ? (qlo | 63) : qlo;
    const int qm = (MODE == 0 ? (qlo | 63) : qlo + r32) - 4 * hi;
    char* V_lds = lds; char* K_lds = lds + 2 * SHM_V;
    float* ws = (float*)(lds + OFF_WS) + wid * 64; float* li_l = ws, * al_l = ws + 32;
    const float* btab = (const float*)(lds + OFF_BIAS) + 4 * hi;
    float m_reg = -1e30f, l_reg = 0; f32x16 o[4] = {};
    float2* stat = (float2*)(lds + OFF_BIAS) + (wid * 2 + (cur.step & 1)) * 32;
    float mnLf = 0.f; (void)mnLf;
    if constexpr (FIXM) { const float2 ml = stat[r32]; m_reg = ml.x; l_reg = ml.y; mnLf = -ml.x * (1.4426950408889634f * SCALE); }
    const int sr = tid >> 4, sc = (tid & 15) * 8, vst0 = v_st(sr, sc), vst1 = v_st(32 + sr, sc), kws = KSWZ(sr, sc * 2);
    const int vb0 = (int)(uintptr_t)V_lds + v_rd_base(lane);
    const int kbase = (int)(uintptr_t)lds, koff = KSWZ(r32, hi * 16);
    const unsigned lo0 = (unsigned)(sr * PITCH + sc) * 2u, lo1 = lo0 + 32u * PITCH * 2u;
    const bf16_t* Kh = cur.K; const bf16_t* Vh = cur.V;
#define KBASE(t) ((MODE == 1 ? NTF - 1 - (t) : (t)) * KVBLK)
#define KBASEN(t) ((MODE == 1 ? NTFn - 1 - (t) : (t)) * KVBLK)
#define RESC(a) do { if (__any((a) < 1.f)) { if (hi == 0) al_l[r32] = (a); asm volatile("s_waitcnt lgkmcnt(0)" ::: "memory");              \
                     for (int d_ = 0; d_ < 4; ++d_) for (int r = 0; r < 16; ++r) o[d_][r] *= al_l[crow(r, hi)]; } } while (0)
#define MASKT(P0_, P1_, t) do { const int kb_ = KBASE(t); if (kb_ + KVBLK - 1 > qlimw) { asm volatile("; mask tile"); mask_tile(P0_, P1_, qm - kb_); } } while (0)
#define BAR() do { asm volatile("s_waitcnt lgkmcnt(0)" ::: "memory"); __builtin_amdgcn_s_barrier(); asm volatile("" ::: "memory"); } while (0)
#define LGK(n) asm volatile("s_waitcnt lgkmcnt(%0)" :: "i"(n) : "memory")
    int jw = 0;
#define LDPAIR(Kp, kk, Vp, vk) do { const char* kq_ = (const char*)((Kp) + (size_t)(kk) * PITCH); const char* vq_ = (const char*)((Vp) + (size_t)(vk) * PITCH);   \
                                    S.st_k0 = *(const bf16x8*)(kq_ + lo0); S.st_k1 = *(const bf16x8*)(kq_ + lo1);                                                    \
                                    S.st_v0 = *(const bf16x8*)(vq_ + lo0); S.st_v1 = *(const bf16x8*)(vq_ + lo1); } while (0)
#define WSTEP() do { if (jw < NT) { VMW();                                                                                                  \
            char* kd_ = K_lds + ((jw + 1) & 1) * SHM_K + kws; char* vd_ = V_lds + (jw & 1) * SHM_V;                                            \
            *(bf16x8*)(kd_) = S.st_k0; *(bf16x8*)(kd_ + 32 * 256) = S.st_k1; *(bf16x8*)(vd_ + vst0) = S.st_v0; *(bf16x8*)(vd_ + vst1) = S.st_v1; \
            asm volatile("" ::: "memory");                                                                                                    \
            const int jn_ = jw + 1;                                                                                                           \
            if (jn_ < NT) { const bool in_ = jn_ + 1 < NT; const bf16_t* kp_ = in_ ? Kh : nxt.K; const int kk_ = in_ ? KBASE(jn_ + 1) : KBASEN(0); \
                            LDPAIR(kp_, kk_, Vh, KBASE(jn_)); }                                                                               \
            else { LDPAIR(nxt.K, KBASEN(1), nxt.V, KBASEN(0)); } }                                                                            \
        ++jw; } while (0)
    f32x16 pX0, pX1; float mnX = 0.f, alX = 1.f; bf16x8 pa0, pa1, pa2, pa3; (void)mnX;
#define TRRD(dst, off) asm volatile("ds_read_b64_tr_b16 %0, %1 offset:%2" : "=&v"(dst) : "v"(vb0), "i"(off) : "memory")
#define RD8(P, VB, d0) do { constexpr int b_ = (VB) * SHM_V + v_rd_off(d0, 0, 0); TRRD(P##l0, b_); TRRD(P##h0, b_ + 2048); TRRD(P##l1, b_ + 4096); TRRD(P##h1, b_ + 6144);  \
                            TRRD(P##l2, b_ + 8192); TRRD(P##h2, b_ + 10240); TRRD(P##l3, b_ + 12288); TRRD(P##h3, b_ + 14336); } while (0)
#define MM4(P, d0) do {                                                                                                                          \
        o[d0] = __builtin_amdgcn_mfma_f32_32x32x16_bf16(pa0, (bf16x8){P##l0[0], P##l0[1], P##l0[2], P##l0[3], P##h0[0], P##h0[1], P##h0[2], P##h0[3]}, o[d0], 0, 0, 0);   \
        o[d0] = __builtin_amdgcn_mfma_f32_32x32x16_bf16(pa1, (bf16x8){P##l1[0], P##l1[1], P##l1[2], P##l1[3], P##h1[0], P##h1[1], P##h1[2], P##h1[3]}, o[d0], 0, 0, 0);   \
        o[d0] = __builtin_amdgcn_mfma_f32_32x32x16_bf16(pa2, (bf16x8){P##l2[0], P##l2[1], P##l2[2], P##l2[3], P##h2[0], P##h2[1], P##h2[2], P##h2[3]}, o[d0], 0, 0, 0);   \
        o[d0] = __builtin_amdgcn_mfma_f32_32x32x16_bf16(pa3, (bf16x8){P##l3[0], P##l3[1], P##l3[2], P##l3[3], P##h3[0], P##h3[1], P##h3[2], P##h3[3]}, o[d0], 0, 0, 0); } while (0)
#define KRD(dst, ad, off) asm volatile("ds_read_b128 %0, %1 offset:%2" : "=&v"(dst) : "v"(ad), "i"(off) : "memory")
#define KR4(P, KB, g) do { const int a0_ = kbase + (koff ^ ((2 * (g)) << 5)), a1_ = kbase + (koff ^ ((2 * (g) + 1) << 5)); constexpr int o_ = 2 * SHM_V + (KB) * SHM_K;    \
        KRD(P##0, a0_, o_); KRD(P##1, a0_, o_ + 8192); KRD(P##2, a1_, o_); KRD(P##3, a1_, o_ + 8192); } while (0)
#define QK4(P, g) do { pX0 = __builtin_amdgcn_mfma_f32_32x32x16_bf16(P##0, S.qr[2 * (g)], pX0, 0, 0, 0); pX1 = __builtin_amdgcn_mfma_f32_32x32x16_bf16(P##1, S.qr[2 * (g)], pX1, 0, 0, 0);   \
        pX0 = __builtin_amdgcn_mfma_f32_32x32x16_bf16(P##2, S.qr[2 * (g) + 1], pX0, 0, 0, 0); pX1 = __builtin_amdgcn_mfma_f32_32x32x16_bf16(P##3, S.qr[2 * (g) + 1], pX1, 0, 0, 0); } while (0)
#define M_SEC(KB, VB, t, QK_, PV_) do { s16x4 Al0, Ah0, Al1, Ah1, Al2, Ah2, Al3, Ah3, Bl0, Bh0, Bl1, Bh1, Bl2, Bh2, Bl3, Bh3;                   \
        bf16x8 G00, G01, G02, G03, G10, G11, G12, G13, G20, G21, G22, G23;                                                                      \
        if (PV_) { RD8(A, VB, 0); RD8(B, VB, 1); SBAR(); }                                                                                      \
        if (QK_) { if constexpr (BIAS) { const float* bp_ = btab + KBASE(t);                                                                    \
                       for (int g_ = 0; g_ < 4; ++g_) { const f32x4 a_ = *(const f32x4*)(bp_ + 8 * g_), b_ = *(const f32x4*)(bp_ + 32 + 8 * g_);  \
                           pX0[4 * g_] = a_[0]; pX0[4 * g_ + 1] = a_[1]; pX0[4 * g_ + 2] = a_[2]; pX0[4 * g_ + 3] = a_[3];                        \
                           pX1[4 * g_] = b_[0]; pX1[4 * g_ + 1] = b_[1]; pX1[4 * g_ + 2] = b_[2]; pX1[4 * g_ + 3] = b_[3]; }                      \
                       asm volatile("" : "+v"(pX0), "+v"(pX1)); }                                                                               \
                   else { pX0 = f32x16{}; pX1 = f32x16{}; } SBAR(); }                                                                            \
        if (PV_) { LGK(8); SBAR(); MM4(A, 0); SBAR(); RD8(A, VB, 2); SBAR(); LGK(8); SBAR(); MM4(B, 1); SBAR(); RD8(B, VB, 3); SBAR();          \
                   LGK(8); SBAR(); MM4(A, 2); SBAR(); }                                                                                         \
        if (QK_) { KR4(G0, KB, 0); KR4(G1, KB, 1); SBAR(); }                                                                                    \
        if (PV_) { if (QK_) LGK(8); else LGK(0); SBAR(); MM4(B, 3); SBAR(); }                                                                   \
        if (QK_) { KR4(G2, KB, 2); SBAR(); LGK(8); SBAR(); QK4(G0, 0); SBAR(); KR4(G0, KB, 3); SBAR(); LGK(8); SBAR(); QK4(G1, 1); SBAR();             \
                   LGK(4); SBAR(); QK4(G2, 2); SBAR(); LGK(0); SBAR(); QK4(G0, 3); SBAR(); } } while (0)
#define V_SEC(t) do { MASKT(pX0, pX1, t);                                                                                                        \
        if constexpr (FIXM) { psm_fix(pX0, pX1, mnLf); fsm_fix(pX0, pX1, pa0, pa1, pa2, pa3); }                                                  \
        else { partialSM(pX0, pX1, m_reg, mnX, alX); finishSM(pX0, pX1, alX, l_reg, pa0, pa1, pa2, pa3); RESC(alX); }                            \
        SBAR(); WSTEP(); } while (0)
    if (grp) { WSTEP(); BAR(); }
    M_SEC(0, 0, 0, true, false); BAR();
    V_SEC(0); BAR();
    for (int t = 1; t + 1 < NT; t += 2) {
        M_SEC(1, 0, t, true, true); BAR();
        V_SEC(t); BAR();
        M_SEC(0, 1, t + 1, true, true); BAR();
        V_SEC(t + 1); BAR();
    }
    M_SEC(1, 0, NT - 1, true, true); BAR();
    V_SEC(NT - 1);
#pragma unroll
    for (int d0 = 0; d0 < 8; ++d0) S.qr[d0] = *(const bf16x8*)(nxt.Q + (size_t)(wid * QBLK + r32) * PITCH + d0 * 16 + hi * 8);
    BAR();
    M_SEC(0, 1, NT, false, true);
    if (!grp) BAR();
    f32x16 tp[4]; int lane_e = lane; asm volatile("" : "+v"(lane_e));
    epi.prefetch(tp, cur, wid, lane_e);
    if constexpr (MODE == 0 && !FIXM) { if (hi == 0) stat[r32] = make_float2(m_reg, l_reg); }
    if (hi == 0) li_l[r32] = l_reg; asm volatile("s_waitcnt lgkmcnt(0)" ::: "memory");
#pragma unroll
    for (int r = 0; r < 16; ++r) { const float rl = __builtin_amdgcn_rcpf(li_l[crow(r, hi)]);
#pragma unroll
        for (int d0 = 0; d0 < 4; ++d0) o[d0][r] *= rl; }
    epi(o, tp, cur, lds, wid, lane_e);
    __syncthreads();
#undef KBASE
#undef KBASEN
#undef RESC
#undef MASKT
#undef BAR
#undef LGK
#undef LDPAIR
#undef WSTEP
#undef TRRD
#undef RD8
#undef MM4
#undef KRD
#undef KR4
#undef QK4
#undef M_SEC
#undef V_SEC
}
#undef ROW
#undef VMW
#undef VMWN
#undef SLOAD_H
#undef SWRITE_HK
#undef SWRITE_HV
#undef SWRITE_H
template <int SM>
__device__ __forceinline__ void store_tile(const f32x16* val, char* lds, int wid, int lane, const bf16_t* __restrict__ gate, bf16_t* __restrict__ dst, unsigned rowbase  , int colbase, const float* __restrict__ colscale, const float* rowscale  ) {
    const int r32 = lane & 31, hi = lane >> 5; float* stg = (float*)(lds + OFF_STG) + wid * 2048;
    const int c4 = (lane & 15) * 4; const unsigned off0 = (rowbase + (unsigned)(lane >> 4)) * (unsigned)PITCH + (unsigned)(colbase + c4);
    uint2 g[2][8];
    if (SM >= 1) {
#pragma unroll
        for (int hh = 0; hh < 2; ++hh)
#pragma unroll
            for (int i = 0; i < 8; ++i) g[hh][i] = *(const uint2*)(gate + off0 + (unsigned)(4 * i) * PITCH + hh * 64); }
#pragma unroll
    for (int hh = 0; hh < 2; ++hh) {
#pragma unroll
        for (int r = 0; r < 16; ++r) { const int row = crow(r, hi); stg[row * 64 + r32] = val[2 * hh][r]; stg[row * 64 + 32 + r32] = val[2 * hh + 1][r]; }
        asm volatile("s_waitcnt lgkmcnt(0)" ::: "memory");
        f32x4 cs = (f32x4){1.f, 1.f, 1.f, 1.f}; if (SM == 2) cs = *(const f32x4*)(colscale + hh * 64 + c4);
#pragma unroll
        for (int i = 0; i < 8; ++i) { const int row = 4 * i + (lane >> 4); f32x4 v = *(const f32x4*)(stg + row * 64 + c4);
            if (SM == 2) { const float rsc = rowscale[row]; v = v * rsc * cs; }
            if (SM >= 1) { const uint2 gg = g[hh][i]; v[0] *= __uint_as_float(gg.x << 16); v[1] *= __uint_as_float(gg.x & 0xffff0000u); v[2] *= __uint_as_float(gg.y << 16); v[3] *= __uint_as_float(gg.y & 0xffff0000u); }
            uint2 w; w.x = cvtpk(v[0], v[1]); w.y = cvtpk(v[2], v[3]);
            *(uint2*)(dst + off0 + (unsigned)(4 * i) * PITCH + hh * 64) = w; }
        asm volatile("s_waitcnt lgkmcnt(0)" ::: "memory");
    }
}
__device__ __forceinline__ void rescale_rows(char* lds, int wid, int lane, const bf16_t* __restrict__ gate, bf16_t* dst, unsigned rowbase, int colbase, const float* __restrict__ colscale, const float* rowscale) {
    const int c4 = (lane & 15) * 4; const unsigned off0 = (rowbase + (unsigned)(lane >> 4)) * (unsigned)PITCH + (unsigned)(colbase + c4);
    uint2 a[2][8], g[2][8];
#pragma unroll
    for (int hh = 0; hh < 2; ++hh)
#pragma unroll
        for (int i = 0; i < 8; ++i) { a[hh][i] = *(const uint2*)(dst + off0 + (unsigned)(4 * i) * PITCH + hh * 64); g[hh][i] = *(const uint2*)(gate + off0 + (unsigned)(4 * i) * PITCH + hh * 64); }
#pragma unroll
    for (int hh = 0; hh < 2; ++hh) { const f32x4 cs = *(const f32x4*)(colscale + hh * 64 + c4);
#pragma unroll
        for (int i = 0; i < 8; ++i) { const float rsc = rowscale[4 * i + (lane >> 4)]; const uint2 aa = a[hh][i], gg = g[hh][i];
            uint2 w; w.x = cvtpk(__uint_as_float(aa.x << 16) * rsc * cs[0] * __uint_as_float(gg.x << 16), __uint_as_float(aa.x & 0xffff0000u) * rsc * cs[1] * __uint_as_float(gg.x & 0xffff0000u));
                     w.y = cvtpk(__uint_as_float(aa.y << 16) * rsc * cs[2] * __uint_as_float(gg.y << 16), __uint_as_float(aa.y & 0xffff0000u) * rsc * cs[3] * __uint_as_float(gg.y & 0xffff0000u));
            *(uint2*)(dst + off0 + (unsigned)(4 * i) * PITCH + hh * 64) = w; } }
}
struct EpiNullA { __device__ __forceinline__ void prefetch(f32x16*, const BlockRef&, int, int) const {}
    __device__ __forceinline__ void operator()(f32x16* o, f32x16*, const BlockRef&, char*, int, int) const { asm volatile("" :: "v"(o[0]), "v"(o[1]), "v"(o[2]), "v"(o[3])); } };
struct EpiFox { const bf16_t* G; bf16_t* AO;
    __device__ __forceinline__ void prefetch(f32x16*, const BlockRef&, int, int) const {}
    __device__ __forceinline__ void operator()(f32x16* o, f32x16*, const BlockRef& cur, char* lds, int wid, int lane) const {
        store_tile<1>(o, lds, wid, lane, G, AO, (unsigned)(cur.row0 + wid * QBLK), cur.head * 128, nullptr, nullptr); } };

__device__ __forceinline__ float half_sum32(float v) {
    v += __int_as_float(__builtin_amdgcn_ds_swizzle(__float_as_int(v), 0x041f)); v += __int_as_float(__builtin_amdgcn_ds_swizzle(__float_as_int(v), 0x081f));
    v += __int_as_float(__builtin_amdgcn_ds_swizzle(__float_as_int(v), 0x101f)); v += __int_as_float(__builtin_amdgcn_ds_swizzle(__float_as_int(v), 0x201f));
    v += __int_as_float(__builtin_amdgcn_ds_swizzle(__float_as_int(v), 0x401f)); return v;
}
struct EpiDiff { const bf16_t* G; bf16_t* AO; const float* gsub; float lam;
    __device__ __forceinline__ void prefetch(f32x16*, const BlockRef&, int, int) const {}
    __device__ __forceinline__ void operator()(f32x16* o, f32x16*, const BlockRef& cur, char* lds, int wid, int lane) const {
        const int r32 = lane & 31, hi = lane >> 5; const int step = cur.step;
        u32x4* sA = (u32x4*)(lds + OFF_STG + wid * 8192) + lane;
        float* ssq_l = (float*)(lds + OFF_SSQ) + wid * 32;
        const unsigned rowbase = (unsigned)(cur.row0 + wid * QBLK);
        if ((step & 1) == 0) {
#pragma unroll
            for (int k = 0; k < 8; ++k) { u32x4 w; w.x = cvtpk(o[0][2 * k], o[1][2 * k]); w.y = cvtpk(o[2][2 * k], o[3][2 * k]); w.z = cvtpk(o[0][2 * k + 1], o[1][2 * k + 1]); w.w = cvtpk(o[2][2 * k + 1], o[3][2 * k + 1]); sA[k * 64] = w; }
        } else {
            const bool fin = step == 3;
#pragma unroll
            for (int k = 0; k < 8; ++k) { const u32x4 w = sA[k * 64];
#pragma unroll
                for (int e = 0; e < 2; ++e) { const int r = 2 * k + e; const unsigned w0 = e ? w.z : w.x, w1 = e ? w.w : w.y;
                    const float d0_ = __uint_as_float(w0 << 16) - lam * o[0][r], d1_ = __uint_as_float(w0 & 0xffff0000u) - lam * o[1][r];
                    const float d2_ = __uint_as_float(w1 << 16) - lam * o[2][r], d3_ = __uint_as_float(w1 & 0xffff0000u) - lam * o[3][r];
                    o[0][r] = d0_; o[1][r] = d1_; o[2][r] = d2_; o[3][r] = d3_;
                    float p = half_sum32((d0_ * d0_ + d1_ * d1_) + (d2_ * d2_ + d3_ * d3_));
                    const float prev = ssq_l[crow(r, hi)]; asm volatile("s_waitcnt lgkmcnt(0)" ::: "memory");
                    const float val = fin ? 0.8f * __builtin_amdgcn_rsqf((p + prev) * (1.0f / 256.f) + 1e-6f) : p;
                    if (r32 == 0) ssq_l[crow(r, hi)] = val; } }
            asm volatile("s_waitcnt lgkmcnt(0)" ::: "memory");
            if (!fin) store_tile<0>(o, lds, wid, lane, nullptr, AO, rowbase, cur.head * 256, nullptr, nullptr);
            else { store_tile<2>(o, lds, wid, lane, G, AO, rowbase, cur.head * 256 + 128, gsub + 128, ssq_l);
                   rescale_rows(lds, wid, lane, G, AO, rowbase, cur.head * 256, gsub, ssq_l); }
        }
    } };
#undef KSWZ
#undef SBAR
}


__device__ __forceinline__ att::BlockRef diff_ref(int L, int s, const bf16_t* Q, const bf16_t* K, const bf16_t* V) {
    const int xcd = L & 7, k = L >> 3, bh = xcd * 8 + (k >> 2), pair = k & 3, b = bh >> 3, h = bh & 7, qb = (s >> 2) ? 7 - pair : pair, pass = s & 3, hh = 2 * h + (pass & 1);
    att::BlockRef r; r.P0 = qb * 256; r.row0 = b * SEQ + qb * 256; r.head = h; r.step = pass; r.jlo = 0;
    r.Q = Q + (size_t)r.row0 * DM + hh * 128; r.K = K + (size_t)b * SEQ * DM + hh * 128; r.V = V + (size_t)b * SEQ * DM + h * 256 + (pass >> 1) * 128; return r;
}
__device__ __forceinline__ int fox_head(int L, const int* ord) { const int g = (L >> 3) >> 2; return ord[g < 8 ? g : 23 - g]; }
__device__ __forceinline__ att::BlockRef fox_ref(int L, int pass, const int* ord, const bf16_t* Q, const bf16_t* K, const bf16_t* V) {
    const int b = L & 7, pair = (L >> 3) & 3, h = fox_head(L, ord), qb = pass ? 7 - pair : pair;
    att::BlockRef r; r.P0 = qb * 256; r.row0 = b * SEQ + qb * 256; r.head = h; r.step = pass; r.jlo = 0;
    r.Q = Q + (size_t)r.row0 * DM + h * 128; r.K = K + (size_t)b * SEQ * DM + h * 128; r.V = V + (size_t)b * SEQ * DM + h * 128; return r;
}
__device__ __forceinline__ void fox_setup(const float* __restrict__ fb, const float* __restrict__ gq, const float* __restrict__ gk, char* lds, const int wave_s) {
    const int lane = lane_id_v(); int* ord = (int*)(lds + att::OFF_SSQ + 1024 + 64); float* tr = (float*)(lds + att::OFF_SSQ + 1024 + 128);
    if (wave_s == 0) {
        float mq = fmaxf(fabsf(gq[lane]), fabsf(gq[lane + 64])), mk = fmaxf(fabsf(gk[lane]), fabsf(gk[lane + 64]));
#pragma unroll
        for (int o = 1; o < 64; o <<= 1) { mq = fmaxf(mq, __shfl_xor(mq, o)); mk = fmaxf(mk, __shfl_xor(mk, o)); }
        if (lane < 16) { const float me = fb[lane]; int rank = 0;
#pragma unroll
            for (int j = 0; j < 16; ++j) { const float o = fb[j]; rank += (o < me || (o == me && j < lane)) ? 1 : 0; }
            ord[rank] = lane; }
        if (lane == 0) tr[0] = 50.0f / att::SCALE + 2.0f * 1.01f * 128.0f * mq * mk;
    }
    __syncthreads();
}
__device__ __forceinline__ int fox_jlo(int P0, char* lds) {
    const int lane = lane_id_v(); const float* tab = (const float*)(lds + att::OFF_BIAS); const float thr = tab[P0] - *(const float*)(lds + att::OFF_SSQ + 1024 + 128);
    const bool skip = lane < (P0 >> 6) && tab[(lane & 31) * 64 + 63] < thr;
    return (int)__builtin_popcountll(__ballot(skip)) & ~1;
}
__device__ __forceinline__ void fox_bias(const float* __restrict__ lf, char* lds, const int wave_s) {
    const int tid = make_tid(wave_s);
    float* tab = (float*)(lds + att::OFF_BIAS); float* wt = (float*)(lds + att::OFF_SSQ + 1024);
    const int lane = tid & 63, wave = tid >> 6;
    const f32x4 v = *(const f32x4*)(lf + 4 * tid);
    const float a0 = v[0], a1 = a0 + v[1], a2 = a1 + v[2], a3 = a2 + v[3];
    float tot = a3;
#pragma unroll
    for (int o = 1; o < 64; o <<= 1) { const float t = __int_as_float(__builtin_amdgcn_ds_bpermute((lane >= o ? lane - o : lane) << 2, __float_as_int(tot))); if (lane >= o) tot += t; }
    if (lane == 63) wt[wave] = tot;
    __syncthreads();
    float base = tot - a3;
    for (int w = 0; w < wave; ++w) base += wt[w];
    const float ns = -1.0f / att::SCALE;
    *(f32x4*)(tab + 4 * tid) = (f32x4){(base + a0) * ns, (base + a1) * ns, (base + a2) * ns, (base + a3) * ns};
    __syncthreads();
}

#define XB_TMO      128
#define XB_XCNT(j)  (256  + 64 * (j))
#define XB_XSUB(j)  (1280 + 64 * (j))
#define XB_XGEN(j)  (2304 + 64 * (j))
#define XB_TOP      3328
#define XB_TOPGEN   3392
#define XCD_BAR_WORDS 8192
#define GB_CNT(g)   (4096 + 64 * (g))
#define GB_GEN(g)   (4608 + 64 * (g))
#define GB_MASK(g)  (5120 + 64 * (g))
#define GB_NPOST(g) (5632 + 64 * (g))
#define XB_SPIN_CAP (1u << 22)
__device__ __forceinline__ unsigned xb_ld(unsigned* p)              { return __hip_atomic_load(p, __ATOMIC_RELAXED, __HIP_MEMORY_SCOPE_AGENT); }
__device__ __forceinline__ unsigned xb_add(unsigned* p, unsigned v) { return __hip_atomic_fetch_add(p, v, __ATOMIC_RELAXED, __HIP_MEMORY_SCOPE_AGENT); }
__device__ __forceinline__ unsigned xb_xcc_id() { return (unsigned)__builtin_amdgcn_s_getreg((3 << 11) | 20) & 0xFu; }
#define XB_SPIN(cond, bar) do { unsigned _sp = 0; while (cond) { __builtin_amdgcn_s_sleep(1); \
    if ((++_sp & 255u) == 0u) { if (xb_ld(&(bar)[XB_TMO])) break; if (_sp > XB_SPIN_CAP) { atomicAdd(&(bar)[XB_TMO], 1u); break; } } } } while (0)
struct XcdBarrier { unsigned* bar; unsigned x; volatile LAS unsigned* st; };
__device__ __forceinline__ void xcd_barrier_complete(unsigned* bar, unsigned x, unsigned G, unsigned& nloc, unsigned& nx) {
    unsigned sum, cnt, mine, sp = 0u;
    for (;;) {
        sum = 0u; cnt = 0u; mine = 0u;
#pragma unroll
        for (unsigned j = 0; j < 16; ++j) { const unsigned c = xb_ld(&bar[XB_XCNT(j)]); sum += c; cnt += (c > 0u) ? 1u : 0u; mine = (j == x) ? c : mine; }
        if (sum == G) break;
        __builtin_amdgcn_s_sleep(1);
        if ((++sp & 255u) == 0u) { if (xb_ld(&bar[XB_TMO])) break; if (sp > XB_SPIN_CAP) { atomicAdd(&bar[XB_TMO], 1u); break; } }
    }
    nloc = mine > 0u ? mine : 1u; nx = cnt > 0u ? cnt : 1u;
}
__device__ __forceinline__ void xcd_barrier(const XcdBarrier& b, const int tid, const unsigned G) {
    asm volatile("s_waitcnt vmcnt(0)" ::: "memory");
    __syncthreads();
    if (tid == 0) {
        unsigned* bar = b.bar;
        __builtin_amdgcn_s_waitcnt(0);
        unsigned nloc = b.st[0], nx = b.st[1];
        if (nloc == 0u) { xcd_barrier_complete(bar, b.x, G, nloc, nx); b.st[0] = nloc; b.st[1] = nx; }
        const unsigned old = xb_add(&bar[XB_XSUB(b.x)], 1u);
        const unsigned gen = old / nloc;
        if (old + 1u == (gen + 1u) * nloc) {
            __builtin_amdgcn_fence(__ATOMIC_RELEASE, "agent");
            asm volatile("s_waitcnt vmcnt(0)" ::: "memory");
            const unsigned og = xb_add(&bar[XB_TOP], 1u);
            const unsigned tg = og / nx;
            if (og + 1u == (tg + 1u) * nx) xb_add(&bar[XB_TOPGEN], 1u);
            else XB_SPIN(xb_ld(&bar[XB_TOPGEN]) == tg, bar);
            __builtin_amdgcn_fence(__ATOMIC_ACQUIRE, "agent");
            xb_add(&bar[XB_XGEN(b.x)], 1u);
            asm volatile("s_waitcnt vmcnt(0)" ::: "memory");
        } else {
            XB_SPIN(xb_ld(&bar[XB_XGEN(b.x)]) == gen, bar);
            __builtin_amdgcn_fence(__ATOMIC_ACQUIRE, "agent");
            asm volatile("s_waitcnt vmcnt(0)" ::: "memory");
        }
    }
    __syncthreads();
}
__device__ __forceinline__ void grp_barrier(unsigned* bar, const int g, const unsigned nmem, volatile LAS unsigned* st, const int tid) {
    asm volatile("s_waitcnt vmcnt(0)" ::: "memory");
    __syncthreads();
    if (tid == 0) {
        __builtin_amdgcn_s_waitcnt(0);
        unsigned mode = st[2];
        if (mode == 0u) {
            const unsigned np = xb_ld(&bar[GB_NPOST(g)]), m = xb_ld(&bar[GB_MASK(g)]);
            if (np == nmem) { mode = (__builtin_popcount(m) == 1) ? 1u : 2u; st[2] = mode; } else mode = 2u; }
        if (mode != 1u) { __builtin_amdgcn_fence(__ATOMIC_RELEASE, "agent"); asm volatile("s_waitcnt vmcnt(0)" ::: "memory"); }
        const unsigned old = xb_add(&bar[GB_CNT(g)], 1u);
        const unsigned gen = old / nmem;
        if (old + 1u == (gen + 1u) * nmem) xb_add(&bar[GB_GEN(g)], 1u);
        else XB_SPIN(xb_ld(&bar[GB_GEN(g)]) == gen, bar);
        __builtin_amdgcn_fence(__ATOMIC_ACQUIRE, "agent");
        asm volatile("s_waitcnt vmcnt(0)" ::: "memory");
    }
    __syncthreads();
}
constexpr size_t WS_BAR = 256 * 1024;
constexpr int LDS_CTL = LDS_BYTES - 64;
struct Args { const void* in[18]; float* out; unsigned char* ws; int ph_lo, ph_hi, li, pad; };

__device__ __forceinline__ unsigned pk2(float lo, float hi) { return (unsigned)f2bf(lo) | ((unsigned)f2bf(hi) << 16); }

struct P0Item { const float* W; const float* g; bf16_t* Wt; int ldw, N, k0, n0; };
__device__ __forceinline__ void p0_decode(int r, const Args& a, unsigned char* ws, P0Item& I) {
    constexpr int I1 = 32 * 128, I2 = 32 * 32, I3 = 32 * 129;
    int nblk;
    if (r < I1) { I.W = (const float*)a.in[3]; I.g = (const float*)a.in[2]; I.Wt = (bf16_t*)(ws + WS_W1T); I.ldw = NQKVG; I.N = NQKVG; nblk = 128; }
    else if (r < I1 + I2) { r -= I1; I.W = (const float*)a.in[11]; I.g = nullptr; I.Wt = (bf16_t*)(ws + WS_W2T); I.ldw = DM; I.N = DM; nblk = 32; }
    else if (r < I1 + I2 + I3) { r -= I1 + I2; I.W = (const float*)a.in[13]; I.g = (const float*)a.in[12]; I.Wt = (bf16_t*)(ws + WS_W3T); I.ldw = NQKVG + NFG; I.N = NQKVG + NFG; nblk = 129; }
    else { r -= I1 + I2 + I3; I.W = (const float*)a.in[17]; I.g = nullptr; I.Wt = (bf16_t*)(ws + WS_W4T); I.ldw = DM; I.N = DM; nblk = 32; }
    const int kb = r / nblk; I.k0 = kb * 64; I.n0 = (r - kb * nblk) * 64;
}
__device__ __forceinline__ void p0_load(const P0Item& I, int lane, f32x4 (&v)[16], float (&gv)[16]) {
    const int c4 = (lane & 15) * 4, kr = lane >> 4; const bool in = I.n0 + c4 < I.N;
    const float* p = I.W + (size_t)(I.k0 + kr) * I.ldw + I.n0 + c4;
#pragma unroll
    for (int i = 0; i < 16; ++i) { v[i] = in ? *(const f32x4*)(p + (size_t)(4 * i) * I.ldw) : (f32x4){0.f, 0.f, 0.f, 0.f}; gv[i] = I.g ? I.g[I.k0 + 4 * i + kr] : 1.0f; }
}
__device__ __forceinline__ void p0_emit(const P0Item& I, int lane, const f32x4 (&v)[16], const float (&gv)[16], LAS float* scr) {
    const int c4 = (lane & 15) * 4, kr = lane >> 4;
#pragma unroll
    for (int i = 0; i < 16; ++i) { LAS float* s = scr + (4 * i + kr) * 65 + c4; s[0] = v[i].x * gv[i]; s[1] = v[i].y * gv[i]; s[2] = v[i].z * gv[i]; s[3] = v[i].w * gv[i]; }
    asm volatile("s_waitcnt lgkmcnt(0)" ::: "memory");
    const int c = lane & 7;
#pragma unroll
    for (int j = 0; j < 8; ++j) { const int n = (lane >> 3) + 8 * j; const LAS float* s = scr + (8 * c) * 65 + n;
        uint4 o; o.x = pk2(s[0], s[65]); o.y = pk2(s[2 * 65], s[3 * 65]); o.z = pk2(s[4 * 65], s[5 * 65]); o.w = pk2(s[6 * 65], s[7 * 65]);
        if (I.n0 + n < I.N) *(uint4*)(I.Wt + (size_t)(I.n0 + n) * DM + I.k0 + 8 * c) = o; }
    asm volatile("s_waitcnt lgkmcnt(0)" ::: "memory");
}

__global__ void __launch_bounds__(NTHREADS, 2) mk_fwd(Args a) {
    extern __shared__ __attribute__((aligned(16))) unsigned char lds_raw[];
    LAS unsigned char* lds = (LAS unsigned char*)lds_raw;
    cg::grid_group grid = cg::this_grid();
    const int G = gridDim.x, bx = blockIdx.x;
    if (a.ph_lo < 0) grid.sync();
    const int wave_s = __builtin_amdgcn_readfirstlane((int)threadIdx.x >> 6);
    if (threadIdx.x < 16) ((LAS unsigned*)(lds + LDS_CTL))[threadIdx.x] = 0u;
    __syncthreads();
    XcdBarrier xbar; xbar.bar = (unsigned*)(a.ws + WS_BAR) + a.li * XCD_BAR_WORDS; xbar.x = xb_xcc_id(); xbar.st = (volatile LAS unsigned*)(lds + LDS_CTL);
    if (threadIdx.x == 0) { (void)xb_add(&xbar.bar[XB_XCNT(xbar.x)], 1u); (void)__hip_atomic_fetch_or(&xbar.bar[GB_MASK(bx & 7)], 1u << xbar.x, __ATOMIC_RELAXED, __HIP_MEMORY_SCOPE_AGENT);
                            __builtin_amdgcn_s_waitcnt(0); (void)xb_add(&xbar.bar[GB_NPOST(bx & 7)], 1u); }
#define GRID_BAR() do { PHASE_IDS(); xcd_barrier(xbar, tid, (unsigned)G); } while (0)
#define GROUP_BAR() do { PHASE_IDS(); if (G == 256) grp_barrier(xbar.bar, bx & 7, 32u, xbar.st, tid); else xcd_barrier(xbar, tid, (unsigned)G); } while (0)
#define PHASE_IDS() const int lane = lane_id_v(), wave = wave_s; const int tid = wave_s * 64 + lane; (void)wave
    unsigned char* ws = a.ws;
    const int lo = a.ph_lo, hi = a.ph_hi;
#if defined(ONLY_PHASE)
#define IN(k) ((k) == ONLY_PHASE && lo <= (k) && (k) < hi)
#elif defined(SKIP_PHASE)
#define IN(k) ((k) != SKIP_PHASE && lo <= (k) && (k) < hi)
#else
#define IN(k) (lo <= (k) && (k) < hi)
#endif
#define BOTH(k) (IN(k) && IN((k) + 1))
#ifdef REPEAT_PHASE
#define REP(k) for (int rep_ = 0; rep_ < ((k) == REPEAT_PHASE ? 2 : 1); ++rep_)
#else
#define REP(k)
#endif
    if (IN(0)) REP(0) {
        PHASE_IDS();
        const int gw = bx * NWAVES + wave, NGW = G * NWAVES;
        LAS float* scr = (LAS float*)(lds + wave * 16640);
        constexpr int NIT = 32 * 128 + 32 * 32 + 32 * 129 + 32 * 32;
        if (gw < NIT) {
            int it = gw; P0Item cur; f32x4 v[16]; float gv[16];
            p0_decode(it, a, ws, cur); p0_load(cur, lane, v, gv);
            for (;;) {
                const int itn = it + NGW; const bool more = itn < NIT;
                P0Item nxt = cur; f32x4 vn[16]; float gn[16];
                if (more) { p0_decode(itn, a, ws, nxt); p0_load(nxt, lane, vn, gn); }
                p0_emit(cur, lane, v, gv, scr);
                if (!more) break;
                cur = nxt; it = itn;
#pragma unroll
                for (int i = 0; i < 16; ++i) { v[i] = vn[i]; gv[i] = gn[i]; }
            }
        }
        { const float* x = (const float*)a.in[0]; bf16_t* xb = (bf16_t*)(ws + WS_XB);
          int row = gw; f32x4 v[8];
          if (row < M) {
            { const f32x4* xr = (const f32x4*)(x + (size_t)row * DM) + lane;
#pragma unroll
              for (int j = 0; j < 8; ++j) v[j] = xr[64 * j]; }
            for (;;) {
                const int rown = row + NGW; const bool more = rown < M; f32x4 vn[8];
                if (more) { const f32x4* xr = (const f32x4*)(x + (size_t)rown * DM) + lane;
#pragma unroll
                    for (int j = 0; j < 8; ++j) vn[j] = xr[64 * j]; }
                float s = 0.f;
#pragma unroll
                for (int j = 0; j < 8; ++j) s += v[j].x * v[j].x + v[j].y * v[j].y + v[j].z * v[j].z + v[j].w * v[j].w;
#pragma unroll
                for (int o = 1; o < 64; o <<= 1) s += __shfl_xor(s, o);
                const float rs = 1.0f / sqrtf(s * (1.0f / DM) + EPS);
                uint2* o8 = (uint2*)(xb + (size_t)row * DM) + lane;
#pragma unroll
                for (int j = 0; j < 8; ++j) { uint2 w; w.x = pk2(v[j].x * rs, v[j].y * rs); w.y = pk2(v[j].z * rs, v[j].w * rs); o8[64 * j] = w; }
                if (!more) break;
                row = rown;
#pragma unroll
                for (int j = 0; j < 8; ++j) v[j] = vn[j];
            } } }
        { const int* pos = (const int*)a.in[1];
          for (int idx = bx * NTHREADS + tid; idx < M * 16; idx += G * NTHREADS) {
            const int row = idx >> 4, i = idx & 15;
            const float inv_freq = (float)exp(-(double)i / 16.0 * log(500000.0));
            float c, s; sincos_acc((float)pos[row] * inv_freq, c, s);
            ((float*)(ws + WS_ROPE_COS))[idx] = c; ((float*)(ws + WS_ROPE_SIN))[idx] = s; }
          if (bx == 0 && wave == 0) {
            const float* lq1 = (const float*)a.in[6]; const float* lk1 = (const float*)a.in[7]; const float* lq2 = (const float*)a.in[8]; const float* lk2 = (const float*)a.in[9];
            float p = lq1[lane] * lk1[lane] + lq1[lane + 64] * lk1[lane + 64], q = lq2[lane] * lk2[lane] + lq2[lane + 64] * lk2[lane + 64];
#pragma unroll
            for (int o = 1; o < 64; o <<= 1) { p += __shfl_xor(p, o); q += __shfl_xor(q, o); }
            if (lane == 0) ((float*)(ws + WS_MISC))[0] = expf(p) - expf(q) + LAMBDA_INIT; } }
        if (BOTH(0)) GRID_BAR();
    }

    if (IN(1)) REP(1) {
        PHASE_IDS();
#ifdef PROBE_GEMM_NOEPI
        { pg8::Gemm g{(const bf16_t*)(ws + WS_XB), (const bf16_t*)(ws + WS_W1T), M, NQKVG, DM}; pg8::StaticOrder S; S.init(M, NQKVG, G, bx, WGM_BIG); pg8::EpiNull E;
          pg8::gemm_phase<pg8::EpiNull, pg8::StaticOrder, true, PG8_SP2>(lds, g, S, E, tid); }
#endif
        pg8::Gemm g{(const bf16_t*)(ws + WS_XB), (const bf16_t*)(ws + WS_W1T), M, NQKVG, DM}; pg8::StaticOrder S; S.init(M, NQKVG, G, bx, WGM_BIG);
        pg8::EpiQKVG<true, false> E{(bf16_t*)(ws + WS_Q), (bf16_t*)(ws + WS_K), (bf16_t*)(ws + WS_V), (bf16_t*)(ws + WS_G), (const float*)(ws + WS_MISC + 65536),
                                    (const float*)a.in[4], (const float*)a.in[5], (const float*)(ws + WS_ROPE_COS), (const float*)(ws + WS_ROPE_SIN), (LAS float*)(lds + EPI_OFF)};
        pg8::gemm_phase<pg8::EpiQKVG<true, false>, pg8::StaticOrder, true, PG8_SP2>(lds, g, S, E, tid);
        if (BOTH(1)) GROUP_BAR();
    }
    if (IN(2)) REP(2) {
        char* ldsg = (char*)lds_raw;
        const bf16_t* Qb = (const bf16_t*)(ws + WS_Q); const bf16_t* Kb = (const bf16_t*)(ws + WS_K); const bf16_t* Vb = (const bf16_t*)(ws + WS_V);
        const att::EpiDiff epi{(const bf16_t*)(ws + WS_G), (bf16_t*)(ws + WS_AO), (const float*)a.in[10], *(const float*)(ws + WS_MISC)};
        constexpr int NITEMS = 256;
        if (bx < NITEMS) {
            att::Seam S; att::BlockRef cur = diff_ref(bx, 0, Qb, Kb, Vb);
            att::attn_prime2<0>(cur, ldsg, S, wave_s);
            for (int L = bx; L < NITEMS; L += G)
                for (int qsel = 0; qsel < 2; ++qsel) {
                    for (int p = 0; p < 2; ++p) { const int s = qsel * 4 + p;
                        const att::BlockRef nxt = diff_ref(L, s + 1, Qb, Kb, Vb);
                        att::attn_block2<0, att::EpiDiff, false>(cur, nxt, ldsg, S, epi, wave_s); cur = nxt; }
                    for (int p = 2; p < 4; ++p) { const int s = qsel * 4 + p; const bool last_of_item = s == 7, more_item = L + G < NITEMS;
                        const att::BlockRef nxt = !last_of_item ? diff_ref(L, s + 1, Qb, Kb, Vb) : (more_item ? diff_ref(L + G, 0, Qb, Kb, Vb) : cur);
                        att::attn_block2<0, att::EpiDiff, true>(cur, nxt, ldsg, S, epi, wave_s); cur = nxt; }
                }
        }
        if (BOTH(2)) GROUP_BAR();
    }
    if (IN(3)) REP(3) {
        PHASE_IDS();
        pg8::Gemm g{(const bf16_t*)(ws + WS_AO), (const bf16_t*)(ws + WS_W2T), M, DM, DM}; pg8::StaticOrder S; S.init(M, DM, G, bx, WGM_SMALL);
        pg8::EpiResMid E{(const float*)a.in[0], (bf16_t*)(ws + WS_XB), (float*)(ws + WS_SSQP), (LAS float*)(lds + EPI_OFF)};
        pg8::gemm_phase<pg8::EpiResMid, pg8::StaticOrder, true, PG8_SP2>(lds, g, S, E, tid);
        if (BOTH(3)) GROUP_BAR();
    }
    if (IN(4)) REP(4) {
        PHASE_IDS();
        {
            const bf16_t* xb = (const bf16_t*)(ws + WS_XB); const bf16_t* wf = (const bf16_t*)(ws + WS_W3T) + (size_t)NQKVG * DM;
            const float* ssqp = (const float*)(ws + WS_SSQP); float* logf_ = (float*)(ws + WS_LOGF); const float* fb = (const float*)a.in[14];
            LAS float* P = (LAS float*)(lds + EPI_OFF);
            for (int rr = bx; rr < M / 64; rr += G) { const int r0 = (G == 256) ? (rr & 7) * SEQ + (rr >> 3) * 64 : rr * 64;
                const int mt = wave & 3, kh = wave >> 2, ar = lane & 15, kq = lane >> 4;
                const bf16_t* ap = xb + (size_t)(r0 + 16 * mt + ar) * DM + kh * 1024 + 8 * kq; const bf16_t* bp = wf + (size_t)ar * DM + kh * 1024 + 8 * kq;
                f32x4 c = (f32x4){0.f, 0.f, 0.f, 0.f};
#pragma unroll 8
                for (int k = 0; k < 1024; k += 32) c = __builtin_amdgcn_mfma_f32_16x16x32_bf16(*(const bf16x8*)(ap + k), *(const bf16x8*)(bp + k), c, 0, 0, 0);
                if (kh == 1) { *(LAS f32x4*)(P + (mt * 64 + lane) * 4) = c; }
                __syncthreads();
                if (kh == 0) { const f32x4 o = *(const LAS f32x4*)(P + (mt * 64 + lane) * 4); const float b = fb[ar];
#pragma unroll
                    for (int j = 0; j < 4; ++j) { const int row = r0 + 16 * mt + 4 * kq + j;
                        const f32x4 pa = *(const f32x4*)(ssqp + (size_t)row * 8), pb = *(const f32x4*)(ssqp + (size_t)row * 8 + 4);
                        const float rs = 1.0f / sqrtf(((pa[0] + pa[1]) + (pa[2] + pa[3]) + (pb[0] + pb[1]) + (pb[2] + pb[3])) * (1.0f / 2048.f) + EPS);
                        const float z = (c[j] + o[j]) * rs + b;
                        logf_[((size_t)(row >> 11) * 16 + ar) * SEQ + (row & (SEQ - 1))] = fminf(z, 0.f) - log1pf(expf(-fabsf(z))); } }
                __syncthreads();
            }
        }
        pg8::Gemm g{(const bf16_t*)(ws + WS_XB), (const bf16_t*)(ws + WS_W3T), M, NQKVG, DM}; pg8::StaticOrder S; S.init(M, NQKVG, G, bx, WGM_BIG);
        pg8::EpiQKVG<false, true> E{(bf16_t*)(ws + WS_Q), (bf16_t*)(ws + WS_K), (bf16_t*)(ws + WS_V), (bf16_t*)(ws + WS_G), (const float*)(ws + WS_SSQP),
                                    (const float*)a.in[15], (const float*)a.in[16], nullptr, nullptr, (LAS float*)(lds + EPI_OFF)};
        pg8::gemm_phase<pg8::EpiQKVG<false, true>, pg8::StaticOrder, true, PG8_SP2>(lds, g, S, E, tid);
        if (BOTH(4)) GROUP_BAR();
    }
    if (IN(5)) REP(5) {
        char* ldsg = (char*)lds_raw;
        const bf16_t* Qb = (const bf16_t*)(ws + WS_Q); const bf16_t* Kb = (const bf16_t*)(ws + WS_K); const bf16_t* Vb = (const bf16_t*)(ws + WS_V);
        const att::EpiFox epi{(const bf16_t*)(ws + WS_G), (bf16_t*)(ws + WS_AO)};
        constexpr int NITEMS = 512;
        const int* ord = (const int*)(ldsg + att::OFF_SSQ + 1024 + 64);
        fox_setup((const float*)a.in[14], (const float*)a.in[15], (const float*)a.in[16], ldsg, wave_s);
        int L = bx, pass = 0;
        if (L < NITEMS) {
            att::Seam S; att::BlockRef cur = fox_ref(L, 0, ord, Qb, Kb, Vb);
            att::attn_prime2<1>(cur, ldsg, S, wave_s);
            for (;;) {
                const bool more_pass = pass == 0, more_item = L + G < NITEMS, last = !more_pass && !more_item;
                const int Ln = more_pass ? L : (more_item ? L + G : L), passn = more_pass ? 1 : 0;
                const att::BlockRef nxt = last ? cur : fox_ref(Ln, passn, ord, Qb, Kb, Vb);
                if (pass == 0) fox_bias((const float*)(ws + WS_LOGF) + (size_t)((L & 7) * 16 + cur.head) * SEQ, ldsg, wave_s);
                cur.jlo = __builtin_amdgcn_readfirstlane(fox_jlo(cur.P0, ldsg));
                att::attn_block2<1, att::EpiFox>(cur, nxt, ldsg, S, epi, wave_s);
                if (last) break;
                cur = nxt; L = Ln; pass = passn;
            }
        }
        if (BOTH(5)) GROUP_BAR();
    }
    if (IN(6)) {
        PHASE_IDS();
        pg8::Gemm g{(const bf16_t*)(ws + WS_AO), (const bf16_t*)(ws + WS_W4T), M, DM, DM}; pg8::StaticOrder S; S.init(M, DM, G, bx, WGM_SMALL);
        pg8::EpiResOut E{(const bf16_t*)(ws + WS_XB), a.out};
        pg8::gemm_phase<pg8::EpiResOut, pg8::StaticOrder, true, PG8_SP2>(lds, g, S, E, tid);
    }
#undef IN
#undef BOTH
}

static int mk_grid() {
    static int grid = 0;
    if (grid == 0) {
        int dev = 0, cus = 0, per_cu = 0;
        if (hipGetDevice(&dev) != hipSuccess || hipDeviceGetAttribute(&cus, hipDeviceAttributeMultiprocessorCount, dev) != hipSuccess) { fprintf(stderr, "mk: device query failed\n"); grid = -1; return grid; }
        if (hipFuncSetAttribute((const void*)mk_fwd, hipFuncAttributeMaxDynamicSharedMemorySize, LDS_BYTES) != hipSuccess) { fprintf(stderr, "mk: hipFuncSetAttribute failed\n"); grid = -1; return grid; }
        if (hipOccupancyMaxActiveBlocksPerMultiprocessor(&per_cu, (const void*)mk_fwd, NTHREADS, LDS_BYTES) != hipSuccess || per_cu < 1) { fprintf(stderr, "mk: occupancy query says %d\n", per_cu); grid = -1; return grid; }
        (void)hipGetLastError();
        grid = cus;
        fprintf(stderr, "mk: cus %d per_cu %d grid %d\n", cus, per_cu, grid);
    }
    return grid;
}
static void mk_launch(void* const* d_in, void* d_out, void* d_ws, int ph_lo, int ph_hi, int li, hipStream_t stream) {
    const int grid = mk_grid(); if (grid <= 0) return;
    Args a{}; for (int i = 0; i < 18; ++i) a.in[i] = d_in[i];
    a.out = (float*)d_out; a.ws = (unsigned char*)d_ws; a.ph_lo = ph_lo; a.ph_hi = ph_hi; a.li = li;
    void* args[] = {&a};
    hipError_t e = hipLaunchCooperativeKernel((const void*)mk_fwd, dim3(grid), dim3(NTHREADS), args, LDS_BYTES, stream);
    if (e != hipSuccess) fprintf(stderr, "mk: cooperative launch failed: %s\n", hipGetErrorString(e));
}

extern "C" void kernel_launch(void* const* d_in, const int* in_sizes, int n_in, void* d_out, int out_size, void* d_ws, size_t ws_size, hipStream_t stream) {
    if (n_in != 18 || in_sizes[0] != M * DM || out_size != M * DM || ws_size < WS_END) { fprintf(stderr, "kernel_launch: unexpected shapes (n_in %d, in0 %d, out %d, ws %zu)\n", n_in, n_in > 0 ? in_sizes[0] : -1, out_size, ws_size); return; }
    (void)hipMemsetAsync((char*)d_ws + WS_BAR, 0, 4 * XCD_BAR_WORDS * 4, stream);
#ifdef PROBE_PHASE
    mk_launch(d_in, d_out, d_ws, 0, PROBE_PHASE + 1, 0, stream); mk_launch(d_in, d_out, d_ws, PROBE_PHASE, 7, 1, stream);
#else
    mk_launch(d_in, d_out, d_ws, 0, 7, 0, stream);
#endif
}
```

```cpp
#include <hip/hip_runtime.h>
#include <hip/hip_cooperative_groups.h>
#include <cstdio>
#include <cstdint>

typedef unsigned short bf16_t;
typedef short bf16x8 __attribute__((ext_vector_type(8)));
typedef float f32x4 __attribute__((ext_vector_type(4)));

constexpr int NB = 8, SEQ = 2048, DM = 2048, M = NB * SEQ;
constexpr int NQKVG = 8192, NFG = 16;
constexpr float EPS = 1e-6f;
constexpr float LAMBDA_INIT = 0.2f;
constexpr float ATT_SCALE = 0.08838834764831845f;

constexpr size_t MiB = 1u << 20;
constexpr size_t WS_MISC = 0;
constexpr size_t WS_ROPE_COS = 1 * MiB, WS_ROPE_SIN = 2 * MiB, WS_LOGF = 3 * MiB, WS_CUM = 4 * MiB;
constexpr size_t WS_W1T = 8 * MiB, WS_W2T = 40 * MiB, WS_W3T = 48 * MiB, WS_W4T = 81 * MiB;
constexpr size_t WS_XB = 96 * MiB, WS_Q = 160 * MiB, WS_K = 224 * MiB, WS_V = 288 * MiB, WS_G = 352 * MiB, WS_AO = 416 * MiB, WS_END = 480 * MiB;

__device__ __forceinline__ unsigned short f2bf(float f) { unsigned u = __float_as_uint(f); return (unsigned short)((u + 0x7fffu + ((u >> 16) & 1u)) >> 16); }
__device__ __forceinline__ float bf2f(unsigned short h) { return __uint_as_float((unsigned)h << 16); }

__device__ __forceinline__ void sincos_acc(float ang, float& c, float& s) {
    const double a = (double)ang, twopi = 6.283185307179586476925286766559;
    const double r = a - rint(a / twopi) * twopi; const double r2 = r * r;
    double ts = r, tc = 1.0, ss = r, cs = 1.0;
#pragma unroll
    for (int i = 1; i <= 14; ++i) { tc *= -r2 / (double)((2 * i - 1) * (2 * i)); ts *= -r2 / (double)((2 * i) * (2 * i + 1)); cs += tc; ss += ts; }
    c = (float)cs; s = (float)ss;
}

namespace pg8 {
#define PG8_LAS __attribute__((address_space(3)))
typedef unsigned short bf16_t;
typedef short bf16x8 __attribute__((ext_vector_type(8)));
typedef float f32x4 __attribute__((ext_vector_type(4)));
typedef unsigned u32x4 __attribute__((ext_vector_type(4)));
constexpr int BM = 256, BK = 64, HALF = 128, HTB = HALF * BK * 2  , STAGE_BYTES = 8 * HTB, NXCD = 8, WGM = 8;

__host__ __device__ __forceinline__ int lds_byte(int r, int c) { const int st = (r >> 4) * 2 + (c >> 5), rr = r & 15, cc = c & 31, ob = rr * 64 + cc * 2; return st * 1024 + (ob ^ (((ob >> 9) & 1) << 5)); }
__host__ __device__ __forceinline__ void stage_rc(int b, int& R, int& C) { const int st = b / 1024, sb = b % 1024, swz = sb ^ (((sb >> 9) & 1) << 5); R = (st >> 1) * 16 + swz / 64; C = (st & 1) * 32 + (swz % 64) / 2; }
__host__ __device__ __forceinline__ int perm32(int rho) { const int n = rho >> 4, i = rho & 15; return 8 * (i >> 2) + 4 * n + (i & 3); }

struct Unit { int pm, pn; };
struct Gemm { const bf16_t* A; const bf16_t* Bt; int M, N, K; };

struct StaticOrder {
    int nM, nN, nwg, G, c, wgm;
    __host__ __device__ void init(int M, int N, int G_, int c_, int wgm_ = WGM) { nM = M / BM; nN = N / BM; nwg = nM * nN; G = G_; c = c_; wgm = wgm_; }
    __host__ __device__ bool next(int i, Unit& u) const {
        const long L = (long)i * G + c; if (L >= nwg) return false;
        int wgid = (int)L; { const int q = nwg / NXCD, r = nwg % NXCD, xcd = wgid % NXCD, off = wgid / NXCD; wgid = (xcd < r ? xcd * (q + 1) : r * (q + 1) + (xcd - r) * q) + off; }
        const int nig = wgm * nN, gid = wgid / nig, fm = gid * wgm, gsz = (nM - fm) < wgm ? (nM - fm) : wgm;
        u.pm = fm + ((wgid % nig) % gsz); u.pn = (wgid % nig) / gsz; return true;
    }
    __device__ __forceinline__ void a_ready(const Unit&) const {}
    __device__ __forceinline__ void done(const Unit&) const {}
};


__device__ __forceinline__ unsigned cvt_pk_bf16(float lo, float hi) { unsigned r; asm volatile("v_cvt_pk_bf16_f32 %0, %1, %2" : "=v"(r) : "v"(lo), "v"(hi)); return r; }
typedef unsigned u32x2 __attribute__((ext_vector_type(2)));
#define PG8_EPI_BARRIER() do { asm volatile("s_waitcnt lgkmcnt(0)" ::: "memory"); __builtin_amdgcn_s_barrier(); asm volatile("" ::: "memory"); } while (0)
template <bool ROPE, bool PARTS> struct EpiQKVG {
    static constexpr bool PERM = true, AFTER_DRAIN = false;
    bf16_t* Q; bf16_t* K; bf16_t* V; bf16_t* G;
    const float* rstd;
    const float* qg; const float* kg; const float* rcos; const float* rsin;
    PG8_LAS float* P;
    __device__ __forceinline__ void operator()(f32x4 (&acc)[2][2][4][2], const Unit& u, int wr, int wc, int fr, int fq) const {
        const int sec = u.pn >> 3, hc = (u.pn & 7) * 256, rl0 = wr * 64 + fr;
#pragma unroll
        for (int ai = 0; ai < 2; ++ai)
#pragma unroll
            for (int m = 0; m < 4; ++m) { if (PARTS) { const int row = u.pm * BM + ai * HALF + rl0 + m * 16;
                const f32x4 a = *(const f32x4*)(rstd + (size_t)row * 8), b = *(const f32x4*)(rstd + (size_t)row * 8 + 4);
                const float rs = __builtin_amdgcn_rsqf(((a[0] + a[1]) + (a[2] + a[3]) + (b[0] + b[1]) + (b[2] + b[3])) * (1.0f / 2048.f) + 1e-6f);
#pragma unroll
                for (int bj = 0; bj < 2; ++bj)
#pragma unroll
                    for (int n = 0; n < 2; ++n) acc[ai][bj][m][n] = acc[ai][bj][m][n] * rs; } }
        if (sec <= 1) {
#pragma unroll
            for (int ai = 0; ai < 2; ++ai)
#pragma unroll
                for (int m = 0; m < 4; ++m) { const int rloc = ai * HALF + rl0 + m * 16;
#pragma unroll
                    for (int bj = 0; bj < 2; ++bj) { const f32x4 a = acc[ai][bj][m][0], b = acc[ai][bj][m][1];
                        float ss = (a[0] * a[0] + a[1] * a[1]) + (a[2] * a[2] + a[3] * a[3]) + (b[0] * b[0] + b[1] * b[1]) + (b[2] * b[2] + b[3] * b[3]);
                        ss += __shfl_xor(ss, 16); ss += __shfl_xor(ss, 32);
                        if (fq == 0) P[rloc * 8 + bj * 4 + wc] = ss; } }
            PG8_EPI_BARRIER();
            const float* gn = (sec == 0 ? qg : kg) + wc * 32 + 8 * fq;
            const f32x4 g0 = *(const f32x4*)gn, g1 = *(const f32x4*)(gn + 4);
            bf16_t* dst = sec == 0 ? Q : K;
#pragma unroll
            for (int ai = 0; ai < 2; ++ai)
#pragma unroll
                for (int m = 0; m < 4; ++m) { const int rloc = ai * HALF + rl0 + m * 16, row = u.pm * BM + rloc;
                    f32x4 c0, c1, s0, s1;
                    if (ROPE && wc == 0) { const float* cp = rcos + (size_t)row * 16 + 8 * (fq & 1); const float* sp = rsin + (size_t)row * 16 + 8 * (fq & 1);
                        c0 = *(const f32x4*)cp; c1 = *(const f32x4*)(cp + 4); s0 = *(const f32x4*)sp; s1 = *(const f32x4*)(sp + 4);
                        if (fq < 2) { s0 = -s0; s1 = -s1; } }
#pragma unroll
                    for (int bj = 0; bj < 2; ++bj) { const f32x4 p4 = *(const PG8_LAS f32x4*)(P + rloc * 8 + bj * 4);
                        const float rh = __builtin_amdgcn_rsqf(((p4[0] + p4[1]) + (p4[2] + p4[3])) * (1.0f / 128.f) + 1e-6f);
                        f32x4 v0 = acc[ai][bj][m][0] * rh * g0, v1 = acc[ai][bj][m][1] * rh * g1;
                        if (ROPE && wc == 0) {
#pragma unroll
                            for (int j = 0; j < 4; ++j) { const float p0 = __shfl_xor(v0[j], 32), p1 = __shfl_xor(v1[j], 32);
                                v0[j] = v0[j] * c0[j] + p0 * s0[j]; v1[j] = v1[j] * c1[j] + p1 * s1[j]; } }
                        u32x4 w; w.x = cvt_pk_bf16(v0[0], v0[1]); w.y = cvt_pk_bf16(v0[2], v0[3]); w.z = cvt_pk_bf16(v1[0], v1[1]); w.w = cvt_pk_bf16(v1[2], v1[3]);
                        *(u32x4*)(dst + (size_t)row * 2048 + hc + bj * HALF + wc * 32 + 8 * fq) = w; } }
        } else {
            bf16_t* dst = sec == 2 ? V : G;
#pragma unroll
            for (int ai = 0; ai < 2; ++ai)
#pragma unroll
                for (int m = 0; m < 4; ++m) { const int row = u.pm * BM + ai * HALF + rl0 + m * 16;
#pragma unroll
                    for (int bj = 0; bj < 2; ++bj) { f32x4 v0 = acc[ai][bj][m][0], v1 = acc[ai][bj][m][1];
                        if (sec == 3) {
#pragma unroll
                            for (int j = 0; j < 4; ++j) { v0[j] = v0[j] * __builtin_amdgcn_rcpf(1.0f + __builtin_amdgcn_exp2f(-1.4426950408889634f * v0[j]));
                                                          v1[j] = v1[j] * __builtin_amdgcn_rcpf(1.0f + __builtin_amdgcn_exp2f(-1.4426950408889634f * v1[j])); } }
                        u32x4 w; w.x = cvt_pk_bf16(v0[0], v0[1]); w.y = cvt_pk_bf16(v0[2], v0[3]); w.z = cvt_pk_bf16(v1[0], v1[1]); w.w = cvt_pk_bf16(v1[2], v1[3]);
                        *(u32x4*)(dst + (size_t)row * 2048 + hc + bj * HALF + wc * 32 + 8 * fq) = w; } }
        }
    }
};

struct EpiNull { static constexpr bool PERM = true, AFTER_DRAIN = false;
    __device__ __forceinline__ void operator()(f32x4 (&acc)[2][2][4][2], const Unit&, int, int, int, int) const {
#pragma unroll
        for (int ai = 0; ai < 2; ++ai)
#pragma unroll
            for (int bj = 0; bj < 2; ++bj)
#pragma unroll
                for (int m = 0; m < 4; ++m)
#pragma unroll
                    for (int n = 0; n < 2; ++n) asm volatile("" :: "v"(acc[ai][bj][m][n])); } };
struct EpiResMid {
    static constexpr bool PERM = false, AFTER_DRAIN = false;
    const float* resid; bf16_t* xb; float* ssqp; PG8_LAS float* P;
    __device__ __forceinline__ void operator()(f32x4 (&acc)[2][2][4][2], const Unit& u, int wr, int wc, int fr, int fq) const {
        const int col0 = u.pn * BM + wc * 32 + 4 * fq, rl0 = wr * 64 + fr;
#pragma unroll
        for (int ai = 0; ai < 2; ++ai)
#pragma unroll
            for (int m = 0; m < 4; ++m) { const int rloc = ai * HALF + rl0 + m * 16; const size_t off = (size_t)(u.pm * BM + rloc) * 2048 + col0; float ss = 0.f;
#pragma unroll
                for (int bj = 0; bj < 2; ++bj)
#pragma unroll
                    for (int n = 0; n < 2; ++n) { const f32x4 r = *(const f32x4*)(resid + off + bj * HALF + n * 16); const f32x4 o = r + acc[ai][bj][m][n];
                        ss += (o[0] * o[0] + o[1] * o[1]) + (o[2] * o[2] + o[3] * o[3]);
                        u32x2 w; w.x = cvt_pk_bf16(o[0], o[1]); w.y = cvt_pk_bf16(o[2], o[3]); *(u32x2*)(xb + off + bj * HALF + n * 16) = w; }
                ss += __shfl_xor(ss, 16); ss += __shfl_xor(ss, 32); if (fq == 0) P[rloc * 4 + wc] = ss;
                if (m & 1) asm volatile("" ::: "memory"); }
        PG8_EPI_BARRIER();
        if (wc == 0 && fq == 0) {
#pragma unroll
            for (int ai = 0; ai < 2; ++ai)
#pragma unroll
                for (int m = 0; m < 4; ++m) { const int rloc = ai * HALF + rl0 + m * 16; const f32x4 p4 = *(const PG8_LAS f32x4*)(P + rloc * 4);
                    ssqp[(size_t)(u.pm * BM + rloc) * 8 + u.pn] = (p4[0] + p4[1]) + (p4[2] + p4[3]); } }
    }
};
struct EpiResOut {
    static constexpr bool PERM = false, AFTER_DRAIN = false;
    const bf16_t* xb; float* out;
    __device__ __forceinline__ void operator()(f32x4 (&acc)[2][2][4][2], const Unit& u, int wr, int wc, int fr, int fq) const {
        const int col0 = u.pn * BM + wc * 32 + 4 * fq, rl0 = wr * 64 + fr;
#pragma unroll
        for (int ai = 0; ai < 2; ++ai)
#pragma unroll
            for (int m = 0; m < 4; ++m) { const size_t off = (size_t)(u.pm * BM + ai * HALF + rl0 + m * 16) * 2048 + col0;
#pragma unroll
                for (int bj = 0; bj < 2; ++bj)
#pragma unroll
                    for (int n = 0; n < 2; ++n) { const u32x2 r = *(const u32x2*)(xb + off + bj * HALF + n * 16);
                        f32x4 o = acc[ai][bj][m][n]; o[0] += __uint_as_float(r.x << 16); o[1] += __uint_as_float(r.x & 0xffff0000u); o[2] += __uint_as_float(r.y << 16); o[3] += __uint_as_float(r.y & 0xffff0000u);
                        *(f32x4*)(out + off + bj * HALF + n * 16) = o; }
                if (m & 1) asm volatile("" ::: "memory"); }
    }
};

template <class Epi, class Sched, bool ALIGN_EPI = false, bool SP2 = false>
__device__ __forceinline__ void gemm_phase(PG8_LAS unsigned char* lds, const Gemm g, const Sched& S, const Epi& E, const int tid) {
    const int wid = __builtin_amdgcn_readfirstlane(tid >> 6), lane = tid & 63, wr = wid >> 2, wc = wid & 3, fr = lane & 15, fq = lane >> 4;
    const int K = g.K, nt = K / BK;
    unsigned voffA[2], voffB[2];
#pragma unroll
    for (int i = 0; i < 2; ++i) { int R, C; stage_rc(tid * 16 + i * 8192, R, C); const int Rb = Epi::PERM ? ((R & ~31) + perm32(R & 31)) : R;
        voffA[i] = (unsigned)(R * K + C) * 2u; voffB[i] = (unsigned)(Rb * K + C) * 2u; }
    const size_t kstep = (size_t)(BK * 2);
    const size_t hstep = (size_t)HALF * K * 2;
    const size_t tstep = 2 * hstep;
    const unsigned ldsw = (unsigned)wid * 1024u;
    const int aoff = lds_byte(wr * 64 + fr, fq * 8), boff = lds_byte(wc * 32 + fr, fq * 8);
#define PG8_SA(b, h) (((b) * 2 + (h)) * HTB)
#define PG8_SB(b, h) ((4 + (b) * 2 + (h)) * HTB)
#define PG8_STAGE(bufoff, gbase, voff) do { _Pragma("unroll") for (int _i = 0; _i < 2; ++_i) \
        __builtin_amdgcn_global_load_lds((const unsigned*)((const char*)(gbase) + (voff)[_i]), (PG8_LAS unsigned*)(lds + (bufoff) + ldsw + _i * 8192), 16, 0, 0); } while (0)
#define PG8_LDA(dst, b, h) do { _Pragma("unroll") for (int m = 0; m < 4; ++m) _Pragma("unroll") for (int k = 0; k < 2; ++k) dst[m][k] = *(const PG8_LAS bf16x8*)(lds + PG8_SA(b, h) + aoff + m * 2048 + k * 1024); } while (0)
#define PG8_LDB(dst, b, h) do { _Pragma("unroll") for (int n = 0; n < 2; ++n) _Pragma("unroll") for (int k = 0; k < 2; ++k) dst[n][k] = *(const PG8_LAS bf16x8*)(lds + PG8_SB(b, h) + boff + n * 2048 + k * 1024); } while (0)
#define PG8_MMA(ai, bj, At, Bt) do { __builtin_amdgcn_s_setprio(1); _Pragma("unroll") for (int m = 0; m < 4; ++m) _Pragma("unroll") for (int n = 0; n < 2; ++n) _Pragma("unroll") for (int k = 0; k < 2; ++k) \
        acc[ai][bj][m][n] = __builtin_amdgcn_mfma_f32_16x16x32_bf16(Bt[n][k], At[m][k], acc[ai][bj][m][n], 0, 0, 0); __builtin_amdgcn_s_setprio(0); } while (0)
#define PG8_WAIT_V(n) asm volatile("s_waitcnt vmcnt(" #n ")" ::: "memory")
#define PG8_WAIT_L(n) asm volatile("s_waitcnt lgkmcnt(" #n ")" ::: "memory")
#define PG8_BAR __builtin_amdgcn_s_barrier()
#define PG8_SCHED __builtin_amdgcn_sched_barrier(0)
    Unit cur, nxt; int ui = 0;
    if (!S.next(0, cur)) return;
    f32x4 acc[2][2][4][2];
#pragma unroll
    for (int a = 0; a < 2; ++a)
#pragma unroll
        for (int b = 0; b < 2; ++b)
#pragma unroll
            for (int m = 0; m < 4; ++m)
#pragma unroll
                for (int n = 0; n < 2; ++n) acc[a][b][m][n] = (f32x4){0.f, 0.f, 0.f, 0.f};
    bf16x8 At[4][2], B0[2][2], B1[2][2];
    const char* cA = (const char*)g.A + (size_t)cur.pm * tstep; const char* cB = (const char*)g.Bt + (size_t)cur.pn * tstep;
    S.a_ready(cur);
    if constexpr (SP2) {
        PG8_STAGE(PG8_SB(0, 0), cB, voffB); PG8_STAGE(PG8_SB(0, 1), cB + hstep, voffB); PG8_STAGE(PG8_SA(0, 0), cA, voffA); PG8_STAGE(PG8_SA(0, 1), cA + hstep, voffA);
        if (wr == 1) PG8_BAR;
        PG8_WAIT_V(2); PG8_BAR;
        PG8_STAGE(PG8_SB(1, 0), cB + kstep, voffB); PG8_STAGE(PG8_SA(1, 0), cA + kstep, voffA); PG8_STAGE(PG8_SB(1, 1), cB + hstep + kstep, voffB);
        PG8_WAIT_V(6); PG8_BAR;
    } else {
        PG8_STAGE(PG8_SB(0, 0), cB, voffB); PG8_STAGE(PG8_SA(0, 0), cA, voffA); PG8_STAGE(PG8_SB(0, 1), cB + hstep, voffB); PG8_STAGE(PG8_SA(0, 1), cA + hstep, voffA);
        if (wr == 1) PG8_BAR;
        PG8_WAIT_V(4); PG8_BAR;
        PG8_STAGE(PG8_SB(1, 0), cB + kstep, voffB); PG8_STAGE(PG8_SA(1, 0), cA + kstep, voffA); PG8_STAGE(PG8_SB(1, 1), cB + hstep + kstep, voffB);
        PG8_WAIT_V(6); PG8_BAR;
    }
    for (;;) {
        const bool has_next = S.next(ui + 1, nxt);
        const char* nA = has_next ? (const char*)g.A + (size_t)nxt.pm * tstep : cA; const char* nB = has_next ? (const char*)g.Bt + (size_t)nxt.pn * tstep : cB;
        for (int t = 0; t < nt; t += 2) {
            const bool last = (t == nt - 2);
            const char* a1 = cA + (size_t)(t + 1) * kstep;
            const char* a2 = last ? nA : cA + (size_t)(t + 2) * kstep; const char* b2 = last ? nB : cB + (size_t)(t + 2) * kstep;
            const char* a3 = a2 + kstep; const char* b3 = b2 + kstep;
            if (last && has_next) S.a_ready(nxt);
            if constexpr (SP2) {
            PG8_LDB(B0, 0, 0); PG8_LDB(B1, 0, 1); PG8_SCHED; PG8_LDA(At, 0, 0); PG8_STAGE(PG8_SA(1, 1), a1 + hstep, voffA);
            PG8_WAIT_V(8); PG8_WAIT_L(0); PG8_BAR; PG8_MMA(0, 0, At, B0); PG8_MMA(0, 1, At, B1); PG8_BAR; PG8_SCHED;
            PG8_LDA(At, 0, 1); PG8_STAGE(PG8_SB(0, 0), b2, voffB); PG8_STAGE(PG8_SB(0, 1), b2 + hstep, voffB); PG8_STAGE(PG8_SA(0, 0), a2, voffA);
            PG8_WAIT_V(8); PG8_WAIT_L(0); PG8_BAR; PG8_MMA(1, 0, At, B0); PG8_MMA(1, 1, At, B1); PG8_BAR; PG8_SCHED;
            PG8_LDB(B0, 1, 0); PG8_LDB(B1, 1, 1); PG8_SCHED; PG8_LDA(At, 1, 0); PG8_STAGE(PG8_SA(0, 1), a2 + hstep, voffA);
            PG8_WAIT_V(8); PG8_WAIT_L(0); PG8_BAR; PG8_MMA(0, 0, At, B0); PG8_MMA(0, 1, At, B1); PG8_BAR; PG8_SCHED;
            PG8_LDA(At, 1, 1); PG8_STAGE(PG8_SB(1, 0), b3, voffB); PG8_STAGE(PG8_SB(1, 1), b3 + hstep, voffB); PG8_STAGE(PG8_SA(1, 0), a3, voffA);
            PG8_WAIT_V(8); PG8_WAIT_L(0); PG8_BAR; PG8_MMA(1, 0, At, B0); PG8_MMA(1, 1, At, B1); PG8_BAR; PG8_SCHED;
            } else {
            PG8_LDB(B0, 0, 0); PG8_SCHED; PG8_LDA(At, 0, 0); PG8_STAGE(PG8_SA(1, 1), a1 + hstep, voffA);
            PG8_WAIT_L(8); PG8_BAR; PG8_WAIT_L(0); PG8_MMA(0, 0, At, B0); PG8_BAR; PG8_SCHED;
            PG8_LDB(B1, 0, 1); PG8_STAGE(PG8_SB(0, 0), b2, voffB);
            PG8_BAR; PG8_WAIT_L(0); PG8_MMA(0, 1, At, B1); PG8_BAR;
            PG8_LDA(At, 0, 1); PG8_STAGE(PG8_SA(0, 0), a2, voffA);
            PG8_BAR; PG8_WAIT_L(0); PG8_MMA(1, 0, At, B0); PG8_BAR; PG8_SCHED;
            PG8_STAGE(PG8_SB(0, 1), b2 + hstep, voffB);
            PG8_WAIT_V(6); PG8_BAR; PG8_MMA(1, 1, At, B1); PG8_BAR;
            PG8_LDB(B0, 1, 0); PG8_SCHED; PG8_LDA(At, 1, 0); PG8_STAGE(PG8_SA(0, 1), a2 + hstep, voffA);
            PG8_WAIT_L(8); PG8_BAR; PG8_WAIT_L(0); PG8_MMA(0, 0, At, B0); PG8_BAR; PG8_SCHED;
            PG8_LDB(B1, 1, 1); PG8_STAGE(PG8_SB(1, 0), b3, voffB);
            PG8_BAR; PG8_WAIT_L(0); PG8_MMA(0, 1, At, B1); PG8_BAR;
            PG8_LDA(At, 1, 1); PG8_STAGE(PG8_SA(1, 0), a3, voffA);
            PG8_BAR; PG8_WAIT_L(0); PG8_MMA(1, 0, At, B0); PG8_BAR; PG8_SCHED;
            PG8_STAGE(PG8_SB(1, 1), b3 + hstep, voffB);
            PG8_WAIT_V(6); PG8_BAR; PG8_MMA(1, 1, At, B1); PG8_BAR;
            }
        }
        if constexpr (ALIGN_EPI) { if (wr == 0) PG8_BAR; }
        if constexpr (!Epi::AFTER_DRAIN) { E(acc, cur, wr, wc, fr, fq); S.done(cur); }
        if (!has_next) break;
#pragma unroll
        for (int a = 0; a < 2; ++a)
#pragma unroll
            for (int b = 0; b < 2; ++b)
#pragma unroll
                for (int m = 0; m < 4; ++m)
#pragma unroll
                    for (int n = 0; n < 2; ++n) acc[a][b][m][n] = (f32x4){0.f, 0.f, 0.f, 0.f};
        cur = nxt; cA = nA; cB = nB; ++ui;
        if constexpr (ALIGN_EPI) { if (wr == 1) PG8_BAR; }
    }
    PG8_WAIT_V(0);
    if constexpr (!ALIGN_EPI) { if (wr == 0) PG8_BAR; }
    PG8_BAR;
    if constexpr (Epi::AFTER_DRAIN) { E.fused(acc, cur, wr, wc, fr, fq, lds, wid, lane); S.done(cur); }
#undef PG8_SA
#undef PG8_SB
#undef PG8_STAGE
#undef PG8_LDA
#undef PG8_LDB
#undef PG8_MMA
#undef PG8_WAIT_V
#undef PG8_WAIT_L
#undef PG8_BAR
#undef PG8_SCHED
}
}

namespace cg = cooperative_groups;
#ifndef WGM_BIG
#define WGM_BIG 4
#endif
#ifndef WGM_SMALL
#define WGM_SMALL 4
#endif
static_assert(8 % WGM_BIG == 0 && 8 % WGM_SMALL == 0, "the group barriers need every batch's 8 row tiles inside one XCD-chunk of the GEMM tile order: the group size must divide 8");
#ifndef PG8_SP2
#define PG8_SP2 true
#endif
#define LAS __attribute__((address_space(3)))
constexpr int NWAVES = 8, NTHREADS = NWAVES * 64;
constexpr int RING_BYTES = 131072;
constexpr int EPI_OFF = RING_BYTES;
constexpr int LDS_BYTES = 147456;
constexpr size_t WS_SSQP = 5 * MiB;

__device__ __forceinline__ int lane_id_v() { int l; asm volatile("v_mbcnt_lo_u32_b32 %0, -1, 0\n\tv_mbcnt_hi_u32_b32 %0, -1, %0" : "=v"(l)); return l; }
__device__ __forceinline__ int make_tid(const int wave_s) { return wave_s * 64 + lane_id_v(); }
namespace att {
typedef short s16x4 __attribute__((ext_vector_type(4)));
typedef float f32x16 __attribute__((ext_vector_type(16)));
typedef unsigned u32x4 __attribute__((ext_vector_type(4)));
constexpr int D = 128, PITCH = 2048, NW = 8, QBLK = 32, KVBLK = 64, QB = NW * QBLK;
constexpr int SHM_V = KVBLK * D * 2, SHM_K = KVBLK * D * 2;
constexpr int OFF_WS = 2 * SHM_V + 2 * SHM_K;
constexpr int OFF_BIAS = OFF_WS + NW * 64 * 4;
constexpr int OFF_SSQ = OFF_BIAS + 2048 * 4;
constexpr int OFF_STG = OFF_SSQ + NW * 32 * 4 + 256;
constexpr int LDS_END = OFF_STG + NW * 8192;
static_assert(OFF_STG % 16 == 0 && LDS_END <= LDS_BYTES, "attention LDS map");
constexpr float SCALE = 0.08838834764831845f, THR = 8.f;
#define KSWZ(row, colB) ((row) * 256 + ((colB) ^ (((row) & 15) << 4)))
#define SBAR() __builtin_amdgcn_sched_barrier(0)
__device__ __forceinline__ int v_st(int k, int c) { const int kk = (k & ~0xC) | ((k & 4) << 1) | ((k & 8) >> 1); return ((kk >> 3) * 4 + (c >> 5)) * 512 + ((kk & 7) * 32 + (c & 31)) * 2; }
__device__ __forceinline__ int v_rd_base(int lane) { return ((lane & 3) << 3) | (((lane >> 2) & 3) << 6) | (((lane >> 4) & 1) << 5) | (((lane >> 5) & 1) << 8); }
constexpr int v_rd_off(int d0, int ks, int half) { return d0 * 512 + ks * 4096 + half * 2048; }
__device__ __forceinline__ int crow(int r, int hi) { return (r & 3) + 8 * (r >> 2) + 4 * hi; }
__device__ __forceinline__ unsigned cvtpk(float lo, float hi) { unsigned r; asm volatile("v_cvt_pk_bf16_f32 %0, %1, %2" : "=v"(r) : "v"(lo), "v"(hi)); return r; }
__device__ __forceinline__ void mask_tile(f32x16& p0, f32x16& p1, int dq) {
    const float NEG = -__builtin_inff();
#pragma unroll
    for (int r = 0; r < 16; ++r) { const int c = (r & 3) + 8 * (r >> 2); if (dq - c < 0) p0[r] = NEG; if (dq - c - 32 < 0) p1[r] = NEG; }
}
__device__ __forceinline__ void partialSM(f32x16& p0, f32x16& p1, float& m_reg, float& mn, float& alpha) {
    float pmax = p0[0]; for (int r = 1; r < 16; ++r) pmax = fmaxf(pmax, p0[r]); for (int r = 0; r < 16; ++r) pmax = fmaxf(pmax, p1[r]);
    { auto rr = __builtin_amdgcn_permlane32_swap(__float_as_uint(pmax), __float_as_uint(pmax), false, false);
      pmax = fmaxf(__uint_as_float(rr[0]), __uint_as_float(rr[1])); }
    constexpr float C2 = 1.4426950408889634f * SCALE;
    if (__builtin_expect(__all((pmax - m_reg) * SCALE <= THR), 1)) { mn = m_reg; alpha = 1.f; }
    else { mn = fmaxf(m_reg, pmax); alpha = __builtin_amdgcn_exp2f((m_reg - mn) * C2); m_reg = mn; }
    const float mnL = -mn * C2;
    for (int r = 0; r < 16; ++r) p0[r] = fmaf(p0[r], C2, mnL); for (int r = 0; r < 16; ++r) p1[r] = fmaf(p1[r], C2, mnL);
    for (int r = 0; r < 16; ++r) p0[r] = __builtin_amdgcn_exp2f(p0[r]);
}
__device__ __forceinline__ void finishSM(f32x16& p0, f32x16& p1, float alpha, float& l_reg, bf16x8& pa0, bf16x8& pa1, bf16x8& pa2, bf16x8& pa3) {
    for (int r = 0; r < 16; ++r) p1[r] = __builtin_amdgcn_exp2f(p1[r]);
    float ps = 0; for (int r = 0; r < 16; ++r) ps += p0[r]; for (int r = 0; r < 16; ++r) ps += p1[r];
    { auto rr = __builtin_amdgcn_permlane32_swap(__float_as_uint(ps), __float_as_uint(ps), false, false);
      ps = __uint_as_float(rr[0]) + __uint_as_float(rr[1]); }
    l_reg = l_reg * alpha + ps;
#define PK4(P, B_, OUT) do { unsigned a0 = cvtpk(P[B_+0], P[B_+1]), a1 = cvtpk(P[B_+2], P[B_+3]);                          \
        unsigned b0 = cvtpk(P[B_+4], P[B_+5]), b1 = cvtpk(P[B_+6], P[B_+7]);                                             \
        auto r0 = __builtin_amdgcn_permlane32_swap(a0, b0, false, false); auto r1 = __builtin_amdgcn_permlane32_swap(a1, b1, false, false); \
        u32x4 w = {r0[0], r1[0], r0[1], r1[1]}; OUT = *reinterpret_cast<bf16x8*>(&w); } while (0)
    PK4(p0, 0, pa0); PK4(p0, 8, pa1); PK4(p1, 0, pa2); PK4(p1, 8, pa3);
#undef PK4
}
template <int KB, bool BIAS, bool NOLDS = false>
__device__ __forceinline__ void qkt(f32x16& p0, f32x16& p1, const char* K_lds, int r32, int hi, const bf16x8* qr, const float* bptr) {
    if constexpr (BIAS) {
#pragma unroll
        for (int g = 0; g < 4; ++g) { const f32x4 a = *(const f32x4*)(bptr + 8 * g), b = *(const f32x4*)(bptr + 32 + 8 * g);
            p0[4 * g] = a[0]; p0[4 * g + 1] = a[1]; p0[4 * g + 2] = a[2]; p0[4 * g + 3] = a[3]; p1[4 * g] = b[0]; p1[4 * g + 1] = b[1]; p1[4 * g + 2] = b[2]; p1[4 * g + 3] = b[3]; }
    } else { p0 = f32x16{}; p1 = f32x16{}; }
#pragma unroll
    for (int d0 = 0; d0 < 8; ++d0) { const char* a = K_lds + KB * SHM_K + KSWZ(r32, (d0 * 16 + hi * 8) * 2);
        bf16x8 b0, b1;
        if constexpr (NOLDS) { b0 = qr[(d0 + 1) & 7]; b1 = qr[(d0 + 2) & 7]; } else { b0 = *reinterpret_cast<const bf16x8*>(a); b1 = *reinterpret_cast<const bf16x8*>(a + 32 * 256); }
        p0 = __builtin_amdgcn_mfma_f32_32x32x16_bf16(b0, qr[d0], p0, 0, 0, 0);
        p1 = __builtin_amdgcn_mfma_f32_32x32x16_bf16(b1, qr[d0], p1, 0, 0, 0); }
}
template <int VB, bool NOLDS = false>
__device__ __forceinline__ void pv_tile(f32x16* o, int vb0, bf16x8 pa0, bf16x8 pa1, bf16x8 pa2, bf16x8 pa3) {
    if constexpr (NOLDS) {
#pragma unroll
        for (int d0 = 0; d0 < 4; ++d0) { o[d0] = __builtin_amdgcn_mfma_f32_32x32x16_bf16(pa0, pa1, o[d0], 0, 0, 0); o[d0] = __builtin_amdgcn_mfma_f32_32x32x16_bf16(pa1, pa2, o[d0], 0, 0, 0);
            o[d0] = __builtin_amdgcn_mfma_f32_32x32x16_bf16(pa2, pa3, o[d0], 0, 0, 0); o[d0] = __builtin_amdgcn_mfma_f32_32x32x16_bf16(pa3, pa0, o[d0], 0, 0, 0); }
        return; }
#define TRRD(dst, off) asm volatile("ds_read_b64_tr_b16 %0, %1 offset:%2" : "=&v"(dst) : "v"(vb0), "i"(off) : "memory")
#define PV_D0(d0) do { s16x4 l0, l1, l2, l3, h0, h1, h2, h3; constexpr int b_ = VB * SHM_V + v_rd_off(d0, 0, 0); \
        TRRD(l0, b_); TRRD(h0, b_ + 2048); TRRD(l1, b_ + 4096); TRRD(h1, b_ + 6144); TRRD(l2, b_ + 8192); TRRD(h2, b_ + 10240); TRRD(l3, b_ + 12288); TRRD(h3, b_ + 14336); \
        asm volatile("s_waitcnt lgkmcnt(0)" ::: "memory"); SBAR();   \
        o[d0] = __builtin_amdgcn_mfma_f32_32x32x16_bf16(pa0, (bf16x8){l0[0], l0[1], l0[2], l0[3], h0[0], h0[1], h0[2], h0[3]}, o[d0], 0, 0, 0);   \
        o[d0] = __builtin_amdgcn_mfma_f32_32x32x16_bf16(pa1, (bf16x8){l1[0], l1[1], l1[2], l1[3], h1[0], h1[1], h1[2], h1[3]}, o[d0], 0, 0, 0);   \
        o[d0] = __builtin_amdgcn_mfma_f32_32x32x16_bf16(pa2, (bf16x8){l2[0], l2[1], l2[2], l2[3], h2[0], h2[1], h2[2], h2[3]}, o[d0], 0, 0, 0);   \
        o[d0] = __builtin_amdgcn_mfma_f32_32x32x16_bf16(pa3, (bf16x8){l3[0], l3[1], l3[2], l3[3], h3[0], h3[1], h3[2], h3[3]}, o[d0], 0, 0, 0); } while (0)
    PV_D0(0); PV_D0(1); PV_D0(2); PV_D0(3);
#undef PV_D0
#undef TRRD
}
template <int VB>
__device__ __forceinline__ void pv_sm(f32x16* o, int vb0, bf16x8 pa0, bf16x8 pa1, bf16x8 pa2, bf16x8 pa3, f32x16& x0, f32x16& x1, float& m_reg, float& mn, float& alpha) {
    constexpr float C2 = 1.4426950408889634f * SCALE;
    float pmax, mnL;
#define TRRD(dst, off) asm volatile("ds_read_b64_tr_b16 %0, %1 offset:%2" : "=&v"(dst) : "v"(vb0), "i"(off) : "memory")
#define PV_RD(d0) s16x4 l0, l1, l2, l3, h0, h1, h2, h3; { constexpr int b_ = VB * SHM_V + v_rd_off(d0, 0, 0); \
        TRRD(l0, b_); TRRD(h0, b_ + 2048); TRRD(l1, b_ + 4096); TRRD(h1, b_ + 6144); TRRD(l2, b_ + 8192); TRRD(h2, b_ + 10240); TRRD(l3, b_ + 12288); TRRD(h3, b_ + 14336); } SBAR()
#define PV_MM(d0) SBAR(); asm volatile("s_waitcnt lgkmcnt(0)" ::: "memory"); SBAR();   \
        o[d0] = __builtin_amdgcn_mfma_f32_32x32x16_bf16(pa0, (bf16x8){l0[0], l0[1], l0[2], l0[3], h0[0], h0[1], h0[2], h0[3]}, o[d0], 0, 0, 0);   \
        o[d0] = __builtin_amdgcn_mfma_f32_32x32x16_bf16(pa1, (bf16x8){l1[0], l1[1], l1[2], l1[3], h1[0], h1[1], h1[2], h1[3]}, o[d0], 0, 0, 0);   \
        o[d0] = __builtin_amdgcn_mfma_f32_32x32x16_bf16(pa2, (bf16x8){l2[0], l2[1], l2[2], l2[3], h2[0], h2[1], h2[2], h2[3]}, o[d0], 0, 0, 0);   \
        o[d0] = __builtin_amdgcn_mfma_f32_32x32x16_bf16(pa3, (bf16x8){l3[0], l3[1], l3[2], l3[3], h3[0], h3[1], h3[2], h3[3]}, o[d0], 0, 0, 0)
    { PV_RD(0);
      pmax = x0[0]; for (int r = 1; r < 16; ++r) pmax = fmaxf(pmax, x0[r]);
      PV_MM(0); }
    { PV_RD(1);
      for (int r = 0; r < 16; ++r) pmax = fmaxf(pmax, x1[r]);
      { auto rr = __builtin_amdgcn_permlane32_swap(__float_as_uint(pmax), __float_as_uint(pmax), false, false); pmax = fmaxf(__uint_as_float(rr[0]), __uint_as_float(rr[1])); }
      const bool keep = __all((pmax - m_reg) * SCALE <= THR);
      mn = keep ? m_reg : fmaxf(m_reg, pmax); alpha = keep ? 1.f : __builtin_amdgcn_exp2f((m_reg - mn) * C2); m_reg = mn; mnL = -mn * C2;
      PV_MM(1); }
    { PV_RD(2);
      for (int r = 0; r < 16; ++r) x0[r] = fmaf(x0[r], C2, mnL); for (int r = 0; r < 16; ++r) x1[r] = fmaf(x1[r], C2, mnL);
      PV_MM(2); }
    { PV_RD(3);
      for (int r = 0; r < 16; ++r) x0[r] = __builtin_amdgcn_exp2f(x0[r]);
      PV_MM(3); }
#undef PV_RD
#undef PV_MM
#undef TRRD
}
__device__ __forceinline__ void psm_fix(f32x16& p0, f32x16& p1, float mnL) {
    constexpr float C2 = 1.4426950408889634f * SCALE;
    for (int r = 0; r < 16; ++r) p0[r] = fmaf(p0[r], C2, mnL); for (int r = 0; r < 16; ++r) p1[r] = fmaf(p1[r], C2, mnL);
    for (int r = 0; r < 16; ++r) p0[r] = __builtin_amdgcn_exp2f(p0[r]);
}
__device__ __forceinline__ void fsm_fix(f32x16& p0, f32x16& p1, bf16x8& pa0, bf16x8& pa1, bf16x8& pa2, bf16x8& pa3) {
    for (int r = 0; r < 16; ++r) p1[r] = __builtin_amdgcn_exp2f(p1[r]);
#define PK4(P, B_, OUT) do { unsigned a0 = cvtpk(P[B_+0], P[B_+1]), a1 = cvtpk(P[B_+2], P[B_+3]);                          \
        unsigned b0 = cvtpk(P[B_+4], P[B_+5]), b1 = cvtpk(P[B_+6], P[B_+7]);                                             \
        auto r0 = __builtin_amdgcn_permlane32_swap(a0, b0, false, false); auto r1 = __builtin_amdgcn_permlane32_swap(a1, b1, false, false); \
        u32x4 w = {r0[0], r1[0], r0[1], r1[1]}; OUT = *reinterpret_cast<bf16x8*>(&w); } while (0)
    PK4(p0, 0, pa0); PK4(p0, 8, pa1); PK4(p1, 0, pa2); PK4(p1, 8, pa3);
#undef PK4
}
template <int VB>
__device__ __forceinline__ void pv_smf(f32x16* o, int vb0, bf16x8 pa0, bf16x8 pa1, bf16x8 pa2, bf16x8 pa3, f32x16& x0, f32x16& x1, float mnL) {
    constexpr float C2 = 1.4426950408889634f * SCALE;
#define TRRD(dst, off) asm volatile("ds_read_b64_tr_b16 %0, %1 offset:%2" : "=&v"(dst) : "v"(vb0), "i"(off) : "memory")
#define PV_RD(d0) s16x4 l0, l1, l2, l3, h0, h1, h2, h3; { constexpr int b_ = VB * SHM_V + v_rd_off(d0, 0, 0); \
        TRRD(l0, b_); TRRD(h0, b_ + 2048); TRRD(l1, b_ + 4096); TRRD(h1, b_ + 6144); TRRD(l2, b_ + 8192); TRRD(h2, b_ + 10240); TRRD(l3, b_ + 12288); TRRD(h3, b_ + 14336); } SBAR()
#define PV_MM(d0) SBAR(); asm volatile("s_waitcnt lgkmcnt(0)" ::: "memory"); SBAR();   \
        o[d0] = __builtin_amdgcn_mfma_f32_32x32x16_bf16(pa0, (bf16x8){l0[0], l0[1], l0[2], l0[3], h0[0], h0[1], h0[2], h0[3]}, o[d0], 0, 0, 0);   \
        o[d0] = __builtin_amdgcn_mfma_f32_32x32x16_bf16(pa1, (bf16x8){l1[0], l1[1], l1[2], l1[3], h1[0], h1[1], h1[2], h1[3]}, o[d0], 0, 0, 0);   \
        o[d0] = __builtin_amdgcn_mfma_f32_32x32x16_bf16(pa2, (bf16x8){l2[0], l2[1], l2[2], l2[3], h2[0], h2[1], h2[2], h2[3]}, o[d0], 0, 0, 0);   \
        o[d0] = __builtin_amdgcn_mfma_f32_32x32x16_bf16(pa3, (bf16x8){l3[0], l3[1], l3[2], l3[3], h3[0], h3[1], h3[2], h3[3]}, o[d0], 0, 0, 0)
    { PV_RD(0); for (int r = 0; r < 16; ++r) x0[r] = fmaf(x0[r], C2, mnL); PV_MM(0); }
    { PV_RD(1); for (int r = 0; r < 16; ++r) x1[r] = fmaf(x1[r], C2, mnL); PV_MM(1); }
    { PV_RD(2); for (int r = 0; r < 8; ++r) x0[r] = __builtin_amdgcn_exp2f(x0[r]); PV_MM(2); }
    { PV_RD(3); for (int r = 8; r < 16; ++r) x0[r] = __builtin_amdgcn_exp2f(x0[r]); PV_MM(3); }
#undef PV_RD
#undef PV_MM
#undef TRRD
}
struct BlockRef { const bf16_t* Q; const bf16_t* K; const bf16_t* V; int P0; int row0; int head; int step; int jlo; };
struct Seam { bf16x8 qr[8]; bf16x8 st_v0, st_v1, st_k0, st_k1; };
#define ROW(p, k0, rr) ((p) + (size_t)((k0) + (rr)) * PITCH + sc)
#define VMW() asm volatile("s_waitcnt vmcnt(0)" ::: "memory")
#define VMWN(n) asm volatile("s_waitcnt vmcnt(%0)" :: "i"(n) : "memory")
#define SLOAD_H(Kp, Vp, k0) do { S.st_v0 = *(const bf16x8*)ROW(Vp, k0, sr); S.st_v1 = *(const bf16x8*)ROW(Vp, k0, 32 + sr);              \
                         S.st_k0 = *(const bf16x8*)ROW(Kp, k0, sr); S.st_k1 = *(const bf16x8*)ROW(Kp, k0, 32 + sr); } while (0)
#define SWRITE_HK(bf) do { *(bf16x8*)(K_lds + (bf) * SHM_K + kws) = S.st_k0; *(bf16x8*)(K_lds + (bf) * SHM_K + kws + 32 * 256) = S.st_k1; } while (0)
#define SWRITE_HV(bf) do { *(bf16x8*)(V_lds + (bf) * SHM_V + vst0) = S.st_v0; *(bf16x8*)(V_lds + (bf) * SHM_V + vst1) = S.st_v1; } while (0)
#define SWRITE_H(bf) do { SWRITE_HV(bf); SWRITE_HK(bf); } while (0)
template <int MODE>
__device__ __forceinline__ void attn_prime(const BlockRef& cur, char* lds, Seam& S, const int wave_s) {
    const int tid = make_tid(wave_s); const int wid = __builtin_amdgcn_readfirstlane(tid >> 6), lane = tid & 63, r32 = lane & 31, hi = lane >> 5;
    const int sr = tid >> 4, sc = (tid & 15) * 8, kws = KSWZ(sr, sc * 2); char* K_lds = lds + 2 * SHM_V;
    for (int d0 = 0; d0 < 8; ++d0) S.qr[d0] = *(const bf16x8*)(cur.Q + (size_t)(wid * QBLK + r32) * PITCH + d0 * 16 + hi * 8);
    SLOAD_H(cur.K, cur.V, (MODE == 1 ? cur.P0 + 3 * KVBLK : 0)); VMW(); SWRITE_HK(0);
    __syncthreads();
}
template <int MODE, class Epi, bool FIXM = false>
__device__ __forceinline__ void attn_block(const BlockRef& cur, const BlockRef& nxt, char* lds, Seam& S, const Epi& epi, const int wave_s) {
    constexpr bool BIAS = MODE == 1;
    const int tid = make_tid(wave_s); const int wid = __builtin_amdgcn_readfirstlane(tid >> 6), lane = tid & 63, r32 = lane & 31, hi = lane >> 5;
    const int NTF = cur.P0 / KVBLK + 4, NT = NTF - (MODE == 1 ? cur.jlo : 0);
    const int qlo = cur.P0 + wid * QBLK;
    const int qlimw = MODE == 0 ? (qlo | 63) : qlo;
    const int qm = (MODE == 0 ? (qlo | 63) : qlo + r32) - 4 * hi;
    char* V_lds = lds; char* K_lds = lds + 2 * SHM_V;
    float* ws = (float*)(lds + OFF_WS) + wid * 64; float* li_l = ws, * al_l = ws + 32;
    const float* btab = (const float*)(lds + OFF_BIAS) + 4 * hi;
    float m_reg = -1e30f, l_reg = 0; f32x16 o[4] = {};
    float2* stat = (float2*)(lds + OFF_BIAS) + (wid * 2 + (cur.step & 1)) * 32;
    float mnLf = 0.f, mA_ = 0.f, alA_ = 1.f; (void)mnLf; (void)mA_; (void)alA_;
    if constexpr (FIXM) { const float2 ml = stat[r32]; m_reg = ml.x; l_reg = ml.y; mnLf = -ml.x * (1.4426950408889634f * SCALE); }
    const int sr = tid >> 4, sc = (tid & 15) * 8, vst0 = v_st(sr, sc), vst1 = v_st(32 + sr, sc), kws = KSWZ(sr, sc * 2);
    const int vb0 = (int)(uintptr_t)V_lds + v_rd_base(lane);
    const bf16_t* Kh = cur.K; const bf16_t* Vh = cur.V;
#define RESC(a) do { if constexpr (!FIXM) if (__any((a) < 1.f)) { if (hi == 0) al_l[r32] = (a); asm volatile("s_waitcnt lgkmcnt(0)" ::: "memory");              \
                     for (int d_ = 0; d_ < 4; ++d_) for (int r = 0; r < 16; ++r) o[d_][r] *= al_l[crow(r, hi)]; } } while (0)
#define KBASE(t) ((MODE == 1 ? NTF - 1 - (t) : (t)) * KVBLK)
#define MASKT(P0_, P1_, t) do { const int kb_ = KBASE(t); if (kb_ + KVBLK - 1 > qlimw) { asm volatile("; mask tile"); mask_tile(P0_, P1_, qm - kb_); } } while (0)
#define SEAM_K0() do { VMWN(8); SWRITE_HK(0); SBAR(); } while (0)
    f32x16 pA0, pA1, pB0, pB1; float mnA = 0.f, mnB = 0.f, alA = 1.f, alB = 1.f; bf16x8 pa0, pa1, pa2, pa3; (void)mnA; (void)mnB;
#define A_QKT(KB, X0, X1, t) qkt<KB, BIAS>(X0, X1, K_lds, r32, hi, S.qr, btab + KBASE(t))
#define A_PV(VB) pv_tile<VB>(o, vb0, pa0, pa1, pa2, pa3)
#define A_PSM(X0, X1, mnX, alX) do { if constexpr (FIXM) psm_fix(X0, X1, mnLf); else partialSM(X0, X1, m_reg, mnX, alX); } while (0)
#define A_FSM(Y0, Y1, alY) do { if constexpr (FIXM) fsm_fix(Y0, Y1, pa0, pa1, pa2, pa3); else finishSM(Y0, Y1, alY, l_reg, pa0, pa1, pa2, pa3); } while (0)
#define A_PVSM(VB, X0, X1, mnX, alX) do { if constexpr (FIXM) pv_smf<VB>(o, vb0, pa0, pa1, pa2, pa3, X0, X1, mnLf); else pv_sm<VB>(o, vb0, pa0, pa1, pa2, pa3, X0, X1, m_reg, mnX, alX); } while (0)
#define A_SLOAD(Kp, Vp, k0) SLOAD_H(Kp, Vp, k0)
#define A_SWRITE(bf) do { VMW(); SWRITE_H(bf); } while (0)
#define A_SYNC() __syncthreads()
    SWRITE_HV(0); SBAR();
    A_SLOAD(Kh, Vh, KBASE(1));
    SBAR(); A_QKT(0, pA0, pA1, 0);
    MASKT(pA0, pA1, 0); A_PSM(pA0, pA1, mnA, alA);
    A_SWRITE(1);
    A_SYNC();
#define HALF_STEP(PX0, PX1, mnX, alX, PY0, PY1, alY, t, KB, VB, SB) do {                                                      \
        SBAR(); A_QKT(KB, PX0, PX1, t);                                                                                      \
        A_FSM(PY0, PY1, alY); SBAR();                                                                                         \
        if ((t) + 1 < NT) { A_SLOAD(Kh, Vh, KBASE((t) + 1)); SBAR(); }                                                        \
        MASKT(PX0, PX1, (t)); A_PVSM(VB, PX0, PX1, mnX, alX);                                                                 \
        A_SYNC();                                                                                                             \
        if ((t) + 1 < NT) { A_SWRITE(SB); }                                                                                   \
        RESC(alX); A_SYNC(); } while (0)
    for (int t = 1; t + 1 < NT; t += 2) {
        HALF_STEP(pB0, pB1, mnB, alB, pA0, pA1, alA, t, 1, 0, 0);
        HALF_STEP(pA0, pA1, mnA, alA, pB0, pB1, alB, t + 1, 0, 1, 1);
    }
    SBAR(); A_QKT(1, pB0, pB1, NT - 1); SBAR();
    SLOAD_H(nxt.K, nxt.V, (MODE == 1 ? nxt.P0 + 3 * KVBLK : 0)); SBAR();
#pragma unroll
    for (int d0 = 0; d0 < 8; ++d0) S.qr[d0] = *(const bf16x8*)(nxt.Q + (size_t)(wid * QBLK + r32) * PITCH + d0 * 16 + hi * 8);
    SBAR();
    A_FSM(pA0, pA1, alA); SBAR();
    MASKT(pB0, pB1, NT - 1); A_PVSM(0, pB0, pB1, mnB, alB); __syncthreads(); RESC(alB);
    A_FSM(pB0, pB1, alB); SBAR(); A_PV(1);
    SBAR(); SEAM_K0();
    f32x16 tp[4]; int lane_e = lane; asm volatile("" : "+v"(lane_e));
    epi.prefetch(tp, cur, wid, lane_e);
    if constexpr (MODE == 0 && !FIXM) { if (hi == 0) stat[r32] = make_float2(m_reg, l_reg); }
    if (hi == 0) li_l[r32] = l_reg; asm volatile("s_waitcnt lgkmcnt(0)" ::: "memory");
#pragma unroll
    for (int r = 0; r < 16; ++r) { const float rl = __builtin_amdgcn_rcpf(li_l[crow(r, hi)]);
#pragma unroll
        for (int d0 = 0; d0 < 4; ++d0) o[d0][r] *= rl; }
    epi(o, tp, cur, lds, wid, lane_e);
    __syncthreads();
#undef A_QKT
#undef A_PV
#undef A_PVSM
#undef A_PSM
#undef A_FSM
#undef A_SLOAD
#undef A_SWRITE
#undef A_SYNC
#undef RESC
#undef KBASE
#undef MASKT
#undef SEAM_K0
#undef HALF_STEP
}

template <int MODE>
__device__ __forceinline__ void attn_prime2(const BlockRef& cur, char* lds, Seam& S, const int wave_s) {
    const int tid = make_tid(wave_s); const int wid = __builtin_amdgcn_readfirstlane(tid >> 6), lane = tid & 63, r32 = lane & 31, hi = lane >> 5;
    const int sr = tid >> 4, sc = (tid & 15) * 8, kws = KSWZ(sr, sc * 2); char* K_lds = lds + 2 * SHM_V;
    for (int d0 = 0; d0 < 8; ++d0) S.qr[d0] = *(const bf16x8*)(cur.Q + (size_t)(wid * QBLK + r32) * PITCH + d0 * 16 + hi * 8);
    const int kb0 = MODE == 1 ? cur.P0 + 3 * KVBLK : 0, kb1 = MODE == 1 ? cur.P0 + 2 * KVBLK : KVBLK;
    const bf16x8 ka = *(const bf16x8*)ROW(cur.K, kb0, sr), kb = *(const bf16x8*)ROW(cur.K, kb0, 32 + sr);
    S.st_k0 = *(const bf16x8*)ROW(cur.K, kb1, sr); S.st_k1 = *(const bf16x8*)ROW(cur.K, kb1, 32 + sr);
    S.st_v0 = *(const bf16x8*)ROW(cur.V, kb0, sr); S.st_v1 = *(const bf16x8*)ROW(cur.V, kb0, 32 + sr);
    *(bf16x8*)(K_lds + kws) = ka; *(bf16x8*)(K_lds + kws + 32 * 256) = kb;
    __syncthreads();
}
template <int MODE, class Epi, bool FIXM = false>
__device__ __forceinline__ void attn_block2(const BlockRef& cur, const BlockRef& nxt, char* lds, Seam& S, const Epi& epi, const int wave_s) {
    constexpr bool BIAS = MODE == 1;
    const int tid = make_tid(wave_s); const int wid = __builtin_amdgcn_readfirstlane(tid >> 6), lane = tid & 63, r32 = lane & 31, hi = lane >> 5;
    const int grp = wave_s >> 2;
    const int NTF = cur.P0 / KVBLK + 4, NT = NTF - (MODE == 1 ? cur.jlo : 0);
    const int NTFn = nxt.P0 / KVBLK + 4;
    const int qlo = cur.P0 + wid * QBLK;
    const int qlimw = MODE == 0 ? (qlo | 63) : qlo;
    const int qm = (MODE == 0 ? (qlo | 63) : qlo + r32) - 4 * hi;
    char* V_lds = lds; char* K_lds = lds + 2 * SHM_V;
    float* ws = (float*)(lds + OFF_WS) + wid * 64; float* li_l = ws, * al_l = ws + 32;
    const float* btab = (const float*)(lds + OFF_BIAS) + 4 * hi;
    float m_reg = -1e30f, l_reg = 0; f32x16 o[4] = {};
    float2* stat = (float2*)(lds + OFF_BIAS) + (wid * 2 + (cur.step & 1)) * 32;
    float mnLf = 0.f; (void)mnLf;
    if constexpr (FIXM) { const float2 ml = stat[r32]; m_reg = ml.x; l_reg = ml.y; mnLf = -ml.x * (1.4426950408889634f * SCALE); }
    const int sr = tid >> 4, sc = (tid & 15) * 8, vst0 = v_st(sr, sc), vst1 = v_st(32 + sr, sc), kws = KSWZ(sr, sc * 2);
    const int vb0 = (int)(uintptr_t)V_lds + v_rd_base(lane);
    const int kbase = (int)(uintptr_t)lds, koff = KSWZ(r32, hi * 16);
    const unsigned lo0 = (unsigned)(sr * PITCH + sc) * 2u, lo1 = lo0 + 32u * PITCH * 2u;
    const bf16_t* Kh = cur.K; const bf16_t* Vh = cur.V;
#define KBASE(t) ((MODE == 1 ? NTF - 1 - (t) : (t)) * KVBLK)
#define KBASEN(t) ((MODE == 1 ? NTFn - 1 - (t) : (t)) * KVBLK)
#define RESC(a) do { if (__any((a) < 1.f)) { if (hi == 0) al_l[r32] = (a); asm volatile("s_waitcnt lgkmcnt(0)" ::: "memory");              \
                     for (int d_ = 0; d_ < 4; ++d_) for (int r = 0; r < 16; ++r) o[d_][r] *= al_l[crow(r, hi)]; } } while (0)
#define MASKT(P0_, P1_, t) do { const int kb_ = KBASE(t); if (kb_ + KVBLK - 1 > qlimw) { asm volatile("; mask tile"); mask_tile(P0_, P1_, qm - kb_); } } while (0)
#define BAR() do { asm volatile("s_waitcnt lgkmcnt(0)" ::: "memory"); __builtin_amdgcn_s_barrier(); asm volatile("" ::: "memory"); } while (0)
#define LGK(n) asm volatile("s_waitcnt lgkmcnt(%0)" :: "i"(n) : "memory")
    int jw = 0;
#define LDPAIR(Kp, kk, Vp, vk) do { const char* kq_ = (const char*)((Kp) + (size_t)(kk) * PITCH); const char* vq_ = (const char*)((Vp) + (size_t)(vk) * PITCH);   \
                                    S.st_k0 = *(const bf16x8*)(kq_ + lo0); S.st_k1 = *(const bf16x8*)(kq_ + lo1);                                                    \
                                    S.st_v0 = *(const bf16x8*)(vq_ + lo0); S.st_v1 = *(const bf16x8*)(vq_ + lo1); } while (0)
#define WSTEP() do { if (jw < NT) { VMW();                                                                                                  \
            char* kd_ = K_lds + ((jw + 1) & 1) * SHM_K + kws; char* vd_ = V_lds + (jw & 1) * SHM_V;                                            \
            *(bf16x8*)(kd_) = S.st_k0; *(bf16x8*)(kd_ + 32 * 256) = S.st_k1; *(bf16x8*)(vd_ + vst0) = S.st_v0; *(bf16x8*)(vd_ + vst1) = S.st_v1; \
            asm volatile("" ::: "memory");                                                                                                    \
            const int jn_ = jw + 1;                                                                                                           \
            if (jn_ < NT) { const bool in_ = jn_ + 1 < NT; const bf16_t* kp_ = in_ ? Kh : nxt.K; const int kk_ = in_ ? KBASE(jn_ + 1) : KBASEN(0); \
                            LDPAIR(kp_, kk_, Vh, KBASE(jn_)); }                                                                               \
            else { LDPAIR(nxt.K, KBASEN(1), nxt.V, KBASEN(0)); } }                                                                            \
        ++jw; } while (0)
    f32x16 pX0, pX1; float mnX = 0.f, alX = 1.f; bf16x8 pa0, pa1, pa2, pa3; (void)mnX;
#define TRRD(dst, off) asm volatile("ds_read_b64_tr_b16 %0, %1 offset:%2" : "=&v"(dst) : "v"(vb0), "i"(off) : "memory")
#define RD8(P, VB, d0) do { constexpr int b_ = (VB) * SHM_V + v_rd_off(d0, 0, 0); TRRD(P##l0, b_); TRRD(P##h0, b_ + 2048); TRRD(P##l1, b_ + 4096); TRRD(P##h1, b_ + 6144);  \
                            TRRD(P##l2, b_ + 8192); TRRD(P##h2, b_ + 10240); TRRD(P##l3, b_ + 12288); TRRD(P##h3, b_ + 14336); } while (0)
#define MM4(P, d0) do {                                                                                                                          \
        o[d0] = __builtin_amdgcn_mfma_f32_32x32x16_bf16(pa0, (bf16x8){P##l0[0], P##l0[1], P##l0[2], P##l0[3], P##h0[0], P##h0[1], P##h0[2], P##h0[3]}, o[d0], 0, 0, 0);   \
        o[d0] = __builtin_amdgcn_mfma_f32_32x32x16_bf16(pa1, (bf16x8){P##l1[0], P##l1[1], P##l1[2], P##l1[3], P##h1[0], P##h1[1], P##h1[2], P##h1[3]}, o[d0], 0, 0, 0);   \
        o[d0] = __builtin_amdgcn_mfma_f32_32x32x16_bf16(pa2, (bf16x8){P##l2[0], P##l2[1], P##l2[2], P##l2[3], P##h2[0], P##h2[1], P##h2[2], P##h2[3]}, o[d0], 0, 0, 0);   \
        o[d0] = __builtin_amdgcn_mfma_f32_32x32x16_bf16(pa3, (bf16x8){P##l3[0], P##l3[1], P##l3[2], P##l3[3], P##h3[0], P##h3[1], P##h3[2], P##h3[3]}, o[d0], 0, 0, 0); } while (0)
#define KRD(dst, ad, off) asm volatile("ds_read_b128 %0, %1 offset:%2" : "=&v"(dst) : "v"(ad), "i"(off) : "memory")
#define KR4(P, KB, g) do { const int a0_ = kbase + (koff ^ ((2 * (g)) << 5)), a1_ = kbase + (koff ^ ((2 * (g) + 1) << 5)); constexpr int o_ = 2 * SHM_V + (KB) * SHM_K;    \
        KRD(P##0, a0_, o_); KRD(P##1, a0_, o_ + 8192); KRD(P##2, a1_, o_); KRD(P##3, a1_, o_ + 8192); } while (0)
#define QK4(P, g) do { pX0 = __builtin_amdgcn_mfma_f32_32x32x16_bf16(P##0, S.qr[2 * (g)], pX0, 0, 0, 0); pX1 = __builtin_amdgcn_mfma_f32_32x32x16_bf16(P##1, S.qr[2 * (g)], pX1, 0, 0, 0);   \
        pX0 = __builtin_amdgcn_mfma_f32_32x32x16_bf16(P##2, S.qr[2 * (g) + 1], pX0, 0, 0, 0); pX1 = __builtin_amdgcn_mfma_f32_32x32x16_bf16(P##3, S.qr[2 * (g) + 1], pX1, 0, 0, 0); } while (0)
#define M_SEC(KB, VB, t, QK_, PV_) do { s16x4 Al0, Ah0, Al1, Ah1, Al2, Ah2, Al3, Ah3, Bl0, Bh0, Bl1, Bh1, Bl2, Bh2, Bl3, Bh3;                   \
        bf16x8 G00, G01, G02, G03, G10, G11, G12, G13, G20, G21, G22, G23;                                                                      \
        if (PV_) { RD8(A, VB, 0); RD8(B, VB, 1); SBAR(); }                                                                                      \
        if (QK_) { if constexpr (BIAS) { const float* bp_ = btab + KBASE(t);                                                                    \
                       for (int g_ = 0; g_ < 4; ++g_) { const f32x4 a_ = *(const f32x4*)(bp_ + 8 * g_), b_ = *(const f32x4*)(bp_ + 32 + 8 * g_);  \
                           pX0[4 * g_] = a_[0]; pX0[4 * g_ + 1] = a_[1]; pX0[4 * g_ + 2] = a_[2]; pX0[4 * g_ + 3] = a_[3];                        \
                           pX1[4 * g_] = b_[0]; pX1[4 * g_ + 1] = b_[1]; pX1[4 * g_ + 2] = b_[2]; pX1[4 * g_ + 3] = b_[3]; }                      \
                       asm volatile("" : "+v"(pX0), "+v"(pX1)); }                                                                               \
                   else { pX0 = f32x16{}; pX1 = f32x16{}; } SBAR(); }                                                                            \
        if (PV_) { LGK(8); SBAR(); MM4(A, 0); SBAR(); RD8(A, VB, 2); SBAR(); LGK(8); SBAR(); MM4(B, 1); SBAR(); RD8(B, VB, 3); SBAR();          \
                   LGK(8); SBAR(); MM4(A, 2); SBAR(); }                                                                                         \
        if (QK_) { KR4(G0, KB, 0); KR4(G1, KB, 1); SBAR(); }                                                                                    \
        if (PV_) { if (QK_) LGK(8); else LGK(0); SBAR(); MM4(B, 3); SBAR(); }                                                                   \
        if (QK_) { KR4(G2, KB, 2); SBAR(); LGK(8); SBAR(); QK4(G0, 0); SBAR(); KR4(G0, KB, 3); SBAR(); LGK(8); SBAR(); QK4(G1, 1); SBAR();             \
                   LGK(4); SBAR(); QK4(G2, 2); SBAR(); LGK(0); SBAR(); QK4(G0, 3); SBAR(); } } while (0)
#define V_SEC(t) do { MASKT(pX0, pX1, t);                                                                                                        \
        if constexpr (FIXM) { psm_fix(pX0, pX1, mnLf); fsm_fix(pX0, pX1, pa0, pa1, pa2, pa3); }                                                  \
        else { partialSM(pX0, pX1, m_reg, mnX, alX); finishSM(pX0, pX1, alX, l_reg, pa0, pa1, pa2, pa3); RESC(alX); }                            \
        SBAR(); WSTEP(); } while (0)
#define BAR_G0() do { if (!grp) BAR(); } while (0)
#define BAR_G1() do { if (grp) BAR(); } while (0)
    if (grp) { WSTEP(); }
    M_SEC(0, 0, 0, true, false); BAR_G1();
    V_SEC(0); BAR_G0();
    for (int t = 1; t + 1 < NT; t += 2) {
        M_SEC(1, 0, t, true, true); BAR_G1();
        V_SEC(t); BAR_G0();
        M_SEC(0, 1, t + 1, true, true); BAR_G1();
        V_SEC(t + 1); BAR_G0();
    }
    M_SEC(1, 0, NT - 1, true, true); BAR_G1();
    V_SEC(NT - 1);
#pragma unroll
    for (int d0 = 0; d0 < 8; ++d0) S.qr[d0] = *(const bf16x8*)(nxt.Q + (size_t)(wid * QBLK + r32) * PITCH + d0 * 16 + hi * 8);
    BAR_G0();
    M_SEC(0, 1, NT, false, true);
    f32x16 tp[4]; int lane_e = lane; asm volatile("" : "+v"(lane_e));
    epi.prefetch(tp, cur, wid, lane_e);
    if constexpr (MODE == 0 && !FIXM) { if (hi == 0) stat[r32] = make_float2(m_reg, l_reg); }
    if (hi == 0) li_l[r32] = l_reg; asm volatile("s_waitcnt lgkmcnt(0)" ::: "memory");
#pragma unroll
    for (int r = 0; r < 16; ++r) { const float rl = __builtin_amdgcn_rcpf(li_l[crow(r, hi)]);
#pragma unroll
        for (int d0 = 0; d0 < 4; ++d0) o[d0][r] *= rl; }
    epi(o, tp, cur, lds, wid, lane_e);
    __syncthreads();
#undef KBASE
#undef KBASEN
#undef RESC
#undef MASKT
#undef BAR
#undef BAR_G0
#undef BAR_G1
#undef LGK
#undef LDPAIR
#undef WSTEP
#undef TRRD
#undef RD8
#undef MM4
#undef KRD
#undef KR4
#undef QK4
#undef M_SEC
#undef V_SEC
}
#undef ROW
#undef VMW
#undef VMWN
#undef SLOAD_H
#undef SWRITE_HK
#undef SWRITE_HV
#undef SWRITE_H
template <int SM>
__device__ __forceinline__ void store_tile(const f32x16* val, char* lds, int wid, int lane, const bf16_t* __restrict__ gate, bf16_t* __restrict__ dst, unsigned rowbase  , int colbase, const float* __restrict__ colscale, const float* rowscale  ) {
    const int r32 = lane & 31, hi = lane >> 5; float* stg = (float*)(lds + OFF_STG) + wid * 2048;
    const int c4 = (lane & 15) * 4; const unsigned off0 = (rowbase + (unsigned)(lane >> 4)) * (unsigned)PITCH + (unsigned)(colbase + c4);
    uint2 g[2][8];
    if (SM >= 1) {
#pragma unroll
        for (int hh = 0; hh < 2; ++hh)
#pragma unroll
            for (int i = 0; i < 8; ++i) g[hh][i] = *(const uint2*)(gate + off0 + (unsigned)(4 * i) * PITCH + hh * 64); }
#pragma unroll
    for (int hh = 0; hh < 2; ++hh) {
#pragma unroll
        for (int r = 0; r < 16; ++r) { const int row = crow(r, hi); stg[row * 64 + r32] = val[2 * hh][r]; stg[row * 64 + 32 + r32] = val[2 * hh + 1][r]; }
        asm volatile("s_waitcnt lgkmcnt(0)" ::: "memory");
        f32x4 cs = (f32x4){1.f, 1.f, 1.f, 1.f}; if (SM == 2) cs = *(const f32x4*)(colscale + hh * 64 + c4);
#pragma unroll
        for (int i = 0; i < 8; ++i) { const int row = 4 * i + (lane >> 4); f32x4 v = *(const f32x4*)(stg + row * 64 + c4);
            if (SM == 2) { const float rsc = rowscale[row]; v = v * rsc * cs; }
            if (SM >= 1) { const uint2 gg = g[hh][i]; v[0] *= __uint_as_float(gg.x << 16); v[1] *= __uint_as_float(gg.x & 0xffff0000u); v[2] *= __uint_as_float(gg.y << 16); v[3] *= __uint_as_float(gg.y & 0xffff0000u); }
            uint2 w; w.x = cvtpk(v[0], v[1]); w.y = cvtpk(v[2], v[3]);
            *(uint2*)(dst + off0 + (unsigned)(4 * i) * PITCH + hh * 64) = w; }
        asm volatile("s_waitcnt lgkmcnt(0)" ::: "memory");
    }
}
__device__ __forceinline__ void rescale_rows(char* lds, int wid, int lane, const bf16_t* __restrict__ gate, bf16_t* dst, unsigned rowbase, int colbase, const float* __restrict__ colscale, const float* rowscale) {
    const int c4 = (lane & 15) * 4; const unsigned off0 = (rowbase + (unsigned)(lane >> 4)) * (unsigned)PITCH + (unsigned)(colbase + c4);
    uint2 a[2][8], g[2][8];
#pragma unroll
    for (int hh = 0; hh < 2; ++hh)
#pragma unroll
        for (int i = 0; i < 8; ++i) { a[hh][i] = *(const uint2*)(dst + off0 + (unsigned)(4 * i) * PITCH + hh * 64); g[hh][i] = *(const uint2*)(gate + off0 + (unsigned)(4 * i) * PITCH + hh * 64); }
#pragma unroll
    for (int hh = 0; hh < 2; ++hh) { const f32x4 cs = *(const f32x4*)(colscale + hh * 64 + c4);
#pragma unroll
        for (int i = 0; i < 8; ++i) { const float rsc = rowscale[4 * i + (lane >> 4)]; const uint2 aa = a[hh][i], gg = g[hh][i];
            uint2 w; w.x = cvtpk(__uint_as_float(aa.x << 16) * rsc * cs[0] * __uint_as_float(gg.x << 16), __uint_as_float(aa.x & 0xffff0000u) * rsc * cs[1] * __uint_as_float(gg.x & 0xffff0000u));
                     w.y = cvtpk(__uint_as_float(aa.y << 16) * rsc * cs[2] * __uint_as_float(gg.y << 16), __uint_as_float(aa.y & 0xffff0000u) * rsc * cs[3] * __uint_as_float(gg.y & 0xffff0000u));
            *(uint2*)(dst + off0 + (unsigned)(4 * i) * PITCH + hh * 64) = w; } }
}
struct EpiNullA { __device__ __forceinline__ void prefetch(f32x16*, const BlockRef&, int, int) const {}
    __device__ __forceinline__ void operator()(f32x16* o, f32x16*, const BlockRef&, char*, int, int) const { asm volatile("" :: "v"(o[0]), "v"(o[1]), "v"(o[2]), "v"(o[3])); } };
struct EpiFox { const bf16_t* G; bf16_t* AO;
    __device__ __forceinline__ void prefetch(f32x16*, const BlockRef&, int, int) const {}
    __device__ __forceinline__ void operator()(f32x16* o, f32x16*, const BlockRef& cur, char* lds, int wid, int lane) const {
        store_tile<1>(o, lds, wid, lane, G, AO, (unsigned)(cur.row0 + wid * QBLK), cur.head * 128, nullptr, nullptr); } };

__device__ __forceinline__ float half_sum32(float v) {
    v += __int_as_float(__builtin_amdgcn_ds_swizzle(__float_as_int(v), 0x041f)); v += __int_as_float(__builtin_amdgcn_ds_swizzle(__float_as_int(v), 0x081f));
    v += __int_as_float(__builtin_amdgcn_ds_swizzle(__float_as_int(v), 0x101f)); v += __int_as_float(__builtin_amdgcn_ds_swizzle(__float_as_int(v), 0x201f));
    v += __int_as_float(__builtin_amdgcn_ds_swizzle(__float_as_int(v), 0x401f)); return v;
}
struct EpiDiff { const bf16_t* G; bf16_t* AO; const float* gsub; float lam;
    __device__ __forceinline__ void prefetch(f32x16*, const BlockRef&, int, int) const {}
    __device__ __forceinline__ void operator()(f32x16* o, f32x16*, const BlockRef& cur, char* lds, int wid, int lane) const {
        const int r32 = lane & 31, hi = lane >> 5; const int step = cur.step;
        u32x4* sA = (u32x4*)(lds + OFF_STG + wid * 8192) + lane;
        float* ssq_l = (float*)(lds + OFF_SSQ) + wid * 32;
        const unsigned rowbase = (unsigned)(cur.row0 + wid * QBLK);
        if ((step & 1) == 0) {
#pragma unroll
            for (int k = 0; k < 8; ++k) { u32x4 w; w.x = cvtpk(o[0][2 * k], o[1][2 * k]); w.y = cvtpk(o[2][2 * k], o[3][2 * k]); w.z = cvtpk(o[0][2 * k + 1], o[1][2 * k + 1]); w.w = cvtpk(o[2][2 * k + 1], o[3][2 * k + 1]); sA[k * 64] = w; }
        } else {
            const bool fin = step == 3;
#pragma unroll
            for (int k = 0; k < 8; ++k) { const u32x4 w = sA[k * 64];
#pragma unroll
                for (int e = 0; e < 2; ++e) { const int r = 2 * k + e; const unsigned w0 = e ? w.z : w.x, w1 = e ? w.w : w.y;
                    const float d0_ = __uint_as_float(w0 << 16) - lam * o[0][r], d1_ = __uint_as_float(w0 & 0xffff0000u) - lam * o[1][r];
                    const float d2_ = __uint_as_float(w1 << 16) - lam * o[2][r], d3_ = __uint_as_float(w1 & 0xffff0000u) - lam * o[3][r];
                    o[0][r] = d0_; o[1][r] = d1_; o[2][r] = d2_; o[3][r] = d3_;
                    float p = half_sum32((d0_ * d0_ + d1_ * d1_) + (d2_ * d2_ + d3_ * d3_));
                    const float prev = ssq_l[crow(r, hi)]; asm volatile("s_waitcnt lgkmcnt(0)" ::: "memory");
                    const float val = fin ? 0.8f * __builtin_amdgcn_rsqf((p + prev) * (1.0f / 256.f) + 1e-6f) : p;
                    if (r32 == 0) ssq_l[crow(r, hi)] = val; } }
            asm volatile("s_waitcnt lgkmcnt(0)" ::: "memory");
            if (!fin) store_tile<0>(o, lds, wid, lane, nullptr, AO, rowbase, cur.head * 256, nullptr, nullptr);
            else { store_tile<2>(o, lds, wid, lane, G, AO, rowbase, cur.head * 256 + 128, gsub + 128, ssq_l);
                   rescale_rows(lds, wid, lane, G, AO, rowbase, cur.head * 256, gsub, ssq_l); }
        }
    } };
#undef KSWZ
#undef SBAR
}


__device__ __forceinline__ att::BlockRef diff_ref(int L, int s, const bf16_t* Q, const bf16_t* K, const bf16_t* V) {
    const int xcd = L & 7, k = L >> 3, bh = xcd * 8 + (k >> 2), pair = k & 3, b = bh >> 3, h = bh & 7, qb = (s >> 2) ? 7 - pair : pair, pass = s & 3, hh = 2 * h + (pass & 1);
    att::BlockRef r; r.P0 = qb * 256; r.row0 = b * SEQ + qb * 256; r.head = h; r.step = pass; r.jlo = 0;
    r.Q = Q + (size_t)r.row0 * DM + hh * 128; r.K = K + (size_t)b * SEQ * DM + hh * 128; r.V = V + (size_t)b * SEQ * DM + h * 256 + (pass >> 1) * 128; return r;
}
__device__ __forceinline__ int fox_head(int L, const int* ord) { const int g = (L >> 3) >> 2; return ord[g < 8 ? g : 23 - g]; }
__device__ __forceinline__ att::BlockRef fox_ref(int L, int pass, const int* ord, const bf16_t* Q, const bf16_t* K, const bf16_t* V) {
    const int b = L & 7, pair = (L >> 3) & 3, h = fox_head(L, ord), qb = pass ? 7 - pair : pair;
    att::BlockRef r; r.P0 = qb * 256; r.row0 = b * SEQ + qb * 256; r.head = h; r.step = pass; r.jlo = 0;
    r.Q = Q + (size_t)r.row0 * DM + h * 128; r.K = K + (size_t)b * SEQ * DM + h * 128; r.V = V + (size_t)b * SEQ * DM + h * 128; return r;
}
__device__ __forceinline__ void fox_setup(const float* __restrict__ fb, const float* __restrict__ gq, const float* __restrict__ gk, char* lds, const int wave_s) {
    const int lane = lane_id_v(); int* ord = (int*)(lds + att::OFF_SSQ + 1024 + 64); float* tr = (float*)(lds + att::OFF_SSQ + 1024 + 128);
    if (wave_s == 0) {
        float mq = fmaxf(fabsf(gq[lane]), fabsf(gq[lane + 64])), mk = fmaxf(fabsf(gk[lane]), fabsf(gk[lane + 64]));
#pragma unroll
        for (int o = 1; o < 64; o <<= 1) { mq = fmaxf(mq, __shfl_xor(mq, o)); mk = fmaxf(mk, __shfl_xor(mk, o)); }
        if (lane < 16) { const float me = fb[lane]; int rank = 0;
#pragma unroll
            for (int j = 0; j < 16; ++j) { const float o = fb[j]; rank += (o < me || (o == me && j < lane)) ? 1 : 0; }
            ord[rank] = lane; }
        if (lane == 0) tr[0] = 50.0f / att::SCALE + 2.0f * 1.01f * 128.0f * mq * mk;
    }
    __syncthreads();
}
__device__ __forceinline__ int fox_jlo(int P0, char* lds) {
    const int lane = lane_id_v(); const float* tab = (const float*)(lds + att::OFF_BIAS); const float thr = tab[P0] - *(const float*)(lds + att::OFF_SSQ + 1024 + 128);
    const bool skip = lane < (P0 >> 6) && tab[(lane & 31) * 64 + 63] < thr;
    return (int)__builtin_popcountll(__ballot(skip)) & ~1;
}
__device__ __forceinline__ void fox_bias(const float* __restrict__ lf, char* lds, const int wave_s) {
    const int tid = make_tid(wave_s);
    float* tab = (float*)(lds + att::OFF_BIAS); float* wt = (float*)(lds + att::OFF_SSQ + 1024);
    const int lane = tid & 63, wave = tid >> 6;
    const f32x4 v = *(const f32x4*)(lf + 4 * tid);
    const float a0 = v[0], a1 = a0 + v[1], a2 = a1 + v[2], a3 = a2 + v[3];
    float tot = a3;
#pragma unroll
    for (int o = 1; o < 64; o <<= 1) { const float t = __int_as_float(__builtin_amdgcn_ds_bpermute((lane >= o ? lane - o : lane) << 2, __float_as_int(tot))); if (lane >= o) tot += t; }
    if (lane == 63) wt[wave] = tot;
    __syncthreads();
    float base = tot - a3;
    for (int w = 0; w < wave; ++w) base += wt[w];
    const float ns = -1.0f / att::SCALE;
    *(f32x4*)(tab + 4 * tid) = (f32x4){(base + a0) * ns, (base + a1) * ns, (base + a2) * ns, (base + a3) * ns};
    __syncthreads();
}

#define XB_TMO      128
#define XB_XCNT(j)  (256  + 64 * (j))
#define XB_XSUB(j)  (1280 + 64 * (j))
#define XB_XGEN(j)  (2304 + 64 * (j))
#define XB_TOP      3328
#define XB_TOPGEN   3392
#define XCD_BAR_WORDS 8192
#define GB_CNT(g)   (4096 + 64 * (g))
#define GB_GEN(g)   (4608 + 64 * (g))
#define GB_MASK(g)  (5120 + 64 * (g))
#define GB_NPOST(g) (5632 + 64 * (g))
#define XB_SPIN_CAP (1u << 22)
__device__ __forceinline__ unsigned xb_ld(unsigned* p)              { return __hip_atomic_load(p, __ATOMIC_RELAXED, __HIP_MEMORY_SCOPE_AGENT); }
__device__ __forceinline__ unsigned xb_add(unsigned* p, unsigned v) { return __hip_atomic_fetch_add(p, v, __ATOMIC_RELAXED, __HIP_MEMORY_SCOPE_AGENT); }
__device__ __forceinline__ unsigned xb_xcc_id() { return (unsigned)__builtin_amdgcn_s_getreg((3 << 11) | 20) & 0xFu; }
#define XB_SPIN(cond, bar) do { unsigned _sp = 0; while (cond) { __builtin_amdgcn_s_sleep(1); \
    if ((++_sp & 255u) == 0u) { if (xb_ld(&(bar)[XB_TMO])) break; if (_sp > XB_SPIN_CAP) { atomicAdd(&(bar)[XB_TMO], 1u); break; } } } } while (0)
struct XcdBarrier { unsigned* bar; unsigned x; volatile LAS unsigned* st; };
__device__ __forceinline__ void xcd_barrier_complete(unsigned* bar, unsigned x, unsigned G, unsigned& nloc, unsigned& nx) {
    unsigned sum, cnt, mine, sp = 0u;
    for (;;) {
        sum = 0u; cnt = 0u; mine = 0u;
#pragma unroll
        for (unsigned j = 0; j < 16; ++j) { const unsigned c = xb_ld(&bar[XB_XCNT(j)]); sum += c; cnt += (c > 0u) ? 1u : 0u; mine = (j == x) ? c : mine; }
        if (sum == G) break;
        __builtin_amdgcn_s_sleep(1);
        if ((++sp & 255u) == 0u) { if (xb_ld(&bar[XB_TMO])) break; if (sp > XB_SPIN_CAP) { atomicAdd(&bar[XB_TMO], 1u); break; } }
    }
    nloc = mine > 0u ? mine : 1u; nx = cnt > 0u ? cnt : 1u;
}
__device__ __forceinline__ void xcd_barrier(const XcdBarrier& b, const int tid, const unsigned G) {
    asm volatile("s_waitcnt vmcnt(0)" ::: "memory");
    __syncthreads();
    if (tid == 0) {
        unsigned* bar = b.bar;
        __builtin_amdgcn_s_waitcnt(0);
        unsigned nloc = b.st[0], nx = b.st[1];
        if (nloc == 0u) { xcd_barrier_complete(bar, b.x, G, nloc, nx); b.st[0] = nloc; b.st[1] = nx; }
        const unsigned old = xb_add(&bar[XB_XSUB(b.x)], 1u);
        const unsigned gen = old / nloc;
        if (old + 1u == (gen + 1u) * nloc) {
            __builtin_amdgcn_fence(__ATOMIC_RELEASE, "agent");
            asm volatile("s_waitcnt vmcnt(0)" ::: "memory");
            const unsigned og = xb_add(&bar[XB_TOP], 1u);
            const unsigned tg = og / nx;
            if (og + 1u == (tg + 1u) * nx) xb_add(&bar[XB_TOPGEN], 1u);
            else XB_SPIN(xb_ld(&bar[XB_TOPGEN]) == tg, bar);
            __builtin_amdgcn_fence(__ATOMIC_ACQUIRE, "agent");
            xb_add(&bar[XB_XGEN(b.x)], 1u);
            asm volatile("s_waitcnt vmcnt(0)" ::: "memory");
        } else {
            XB_SPIN(xb_ld(&bar[XB_XGEN(b.x)]) == gen, bar);
            __builtin_amdgcn_fence(__ATOMIC_ACQUIRE, "agent");
            asm volatile("s_waitcnt vmcnt(0)" ::: "memory");
        }
    }
    __syncthreads();
}
__device__ __forceinline__ void grp_barrier(unsigned* bar, const int g, const unsigned nmem, volatile LAS unsigned* st, const int tid) {
    asm volatile("s_waitcnt vmcnt(0)" ::: "memory");
    __syncthreads();
    if (tid == 0) {
        __builtin_amdgcn_s_waitcnt(0);
        unsigned mode = st[2];
        if (mode == 0u) {
            const unsigned np = xb_ld(&bar[GB_NPOST(g)]), m = xb_ld(&bar[GB_MASK(g)]);
            if (np == nmem) { mode = (__builtin_popcount(m) == 1) ? 1u : 2u; st[2] = mode; } else mode = 2u; }
        if (mode != 1u) { __builtin_amdgcn_fence(__ATOMIC_RELEASE, "agent"); asm volatile("s_waitcnt vmcnt(0)" ::: "memory"); }
        const unsigned old = xb_add(&bar[GB_CNT(g)], 1u);
        const unsigned gen = old / nmem;
        if (old + 1u == (gen + 1u) * nmem) xb_add(&bar[GB_GEN(g)], 1u);
        else XB_SPIN(xb_ld(&bar[GB_GEN(g)]) == gen, bar);
        __builtin_amdgcn_fence(__ATOMIC_ACQUIRE, "agent");
        asm volatile("s_waitcnt vmcnt(0)" ::: "memory");
    }
    __syncthreads();
}
constexpr size_t WS_BAR = 256 * 1024;
constexpr int LDS_CTL = LDS_BYTES - 64;
struct Args { const void* in[18]; float* out; unsigned char* ws; int ph_lo, ph_hi, li, pad; };

__device__ __forceinline__ unsigned pk2(float lo, float hi) { return (unsigned)f2bf(lo) | ((unsigned)f2bf(hi) << 16); }

struct P0Item { const float* W; const float* g; bf16_t* Wt; int ldw, N, k0, n0; };
__device__ __forceinline__ void p0_decode(int r, const Args& a, unsigned char* ws, P0Item& I) {
    constexpr int I1 = 32 * 128, I2 = 32 * 32, I3 = 32 * 129;
    int nblk;
    if (r < I1) { I.W = (const float*)a.in[3]; I.g = (const float*)a.in[2]; I.Wt = (bf16_t*)(ws + WS_W1T); I.ldw = NQKVG; I.N = NQKVG; nblk = 128; }
    else if (r < I1 + I2) { r -= I1; I.W = (const float*)a.in[11]; I.g = nullptr; I.Wt = (bf16_t*)(ws + WS_W2T); I.ldw = DM; I.N = DM; nblk = 32; }
    else if (r < I1 + I2 + I3) { r -= I1 + I2; I.W = (const float*)a.in[13]; I.g = (const float*)a.in[12]; I.Wt = (bf16_t*)(ws + WS_W3T); I.ldw = NQKVG + NFG; I.N = NQKVG + NFG; nblk = 129; }
    else { r -= I1 + I2 + I3; I.W = (const float*)a.in[17]; I.g = nullptr; I.Wt = (bf16_t*)(ws + WS_W4T); I.ldw = DM; I.N = DM; nblk = 32; }
    const int kb = r / nblk; I.k0 = kb * 64; I.n0 = (r - kb * nblk) * 64;
}
__device__ __forceinline__ void p0_load(const P0Item& I, int lane, f32x4 (&v)[16], float (&gv)[16]) {
    const int c4 = (lane & 15) * 4, kr = lane >> 4; const bool in = I.n0 + c4 < I.N;
    const float* p = I.W + (size_t)(I.k0 + kr) * I.ldw + I.n0 + c4;
#pragma unroll
    for (int i = 0; i < 16; ++i) { v[i] = in ? *(const f32x4*)(p + (size_t)(4 * i) * I.ldw) : (f32x4){0.f, 0.f, 0.f, 0.f}; gv[i] = I.g ? I.g[I.k0 + 4 * i + kr] : 1.0f; }
}
__device__ __forceinline__ void p0_emit(const P0Item& I, int lane, const f32x4 (&v)[16], const float (&gv)[16], LAS float* scr) {
    const int c4 = (lane & 15) * 4, kr = lane >> 4;
#pragma unroll
    for (int i = 0; i < 16; ++i) { LAS float* s = scr + (4 * i + kr) * 65 + c4; s[0] = v[i].x * gv[i]; s[1] = v[i].y * gv[i]; s[2] = v[i].z * gv[i]; s[3] = v[i].w * gv[i]; }
    asm volatile("s_waitcnt lgkmcnt(0)" ::: "memory");
    const int c = lane & 7;
#pragma unroll
    for (int j = 0; j < 8; ++j) { const int n = (lane >> 3) + 8 * j; const LAS float* s = scr + (8 * c) * 65 + n;
        uint4 o; o.x = pk2(s[0], s[65]); o.y = pk2(s[2 * 65], s[3 * 65]); o.z = pk2(s[4 * 65], s[5 * 65]); o.w = pk2(s[6 * 65], s[7 * 65]);
        if (I.n0 + n < I.N) *(uint4*)(I.Wt + (size_t)(I.n0 + n) * DM + I.k0 + 8 * c) = o; }
    asm volatile("s_waitcnt lgkmcnt(0)" ::: "memory");
}

__global__ void __launch_bounds__(NTHREADS, 2) mk_fwd(Args a) {
    extern __shared__ __attribute__((aligned(16))) unsigned char lds_raw[];
    LAS unsigned char* lds = (LAS unsigned char*)lds_raw;
    cg::grid_group grid = cg::this_grid();
    const int G = gridDim.x, bx = blockIdx.x;
    if (a.ph_lo < 0) grid.sync();
    const int wave_s = __builtin_amdgcn_readfirstlane((int)threadIdx.x >> 6);
    if (threadIdx.x < 16) ((LAS unsigned*)(lds + LDS_CTL))[threadIdx.x] = 0u;
    __syncthreads();
    XcdBarrier xbar; xbar.bar = (unsigned*)(a.ws + WS_BAR) + a.li * XCD_BAR_WORDS; xbar.x = xb_xcc_id(); xbar.st = (volatile LAS unsigned*)(lds + LDS_CTL);
    if (threadIdx.x == 0) { (void)xb_add(&xbar.bar[XB_XCNT(xbar.x)], 1u); (void)__hip_atomic_fetch_or(&xbar.bar[GB_MASK(bx & 7)], 1u << xbar.x, __ATOMIC_RELAXED, __HIP_MEMORY_SCOPE_AGENT);
                            __builtin_amdgcn_s_waitcnt(0); (void)xb_add(&xbar.bar[GB_NPOST(bx & 7)], 1u); }
#define GRID_BAR() do { PHASE_IDS(); xcd_barrier(xbar, tid, (unsigned)G); } while (0)
#define GROUP_BAR() do { PHASE_IDS(); if (G == 256) grp_barrier(xbar.bar, bx & 7, 32u, xbar.st, tid); else xcd_barrier(xbar, tid, (unsigned)G); } while (0)
#define PHASE_IDS() const int lane = lane_id_v(), wave = wave_s; const int tid = wave_s * 64 + lane; (void)wave
    unsigned char* ws = a.ws;
    const int lo = a.ph_lo, hi = a.ph_hi;
#if defined(ONLY_PHASE)
#define IN(k) ((k) == ONLY_PHASE && lo <= (k) && (k) < hi)
#elif defined(SKIP_PHASE)
#define IN(k) ((k) != SKIP_PHASE && lo <= (k) && (k) < hi)
#else
#define IN(k) (lo <= (k) && (k) < hi)
#endif
#define BOTH(k) (IN(k) && IN((k) + 1))
#ifdef REPEAT_PHASE
#define REP(k) for (int rep_ = 0; rep_ < ((k) == REPEAT_PHASE ? 2 : 1); ++rep_)
#else
#define REP(k)
#endif
    if (IN(0)) REP(0) {
        PHASE_IDS();
        const int gw = bx * NWAVES + wave, NGW = G * NWAVES;
        LAS float* scr = (LAS float*)(lds + wave * 16640);
        constexpr int NIT = 32 * 128 + 32 * 32 + 32 * 129 + 32 * 32;
        if (gw < NIT) {
            int it = gw; P0Item cur; f32x4 v[16]; float gv[16];
            p0_decode(it, a, ws, cur); p0_load(cur, lane, v, gv);
            for (;;) {
                const int itn = it + NGW; const bool more = itn < NIT;
                P0Item nxt = cur; f32x4 vn[16]; float gn[16];
                if (more) { p0_decode(itn, a, ws, nxt); p0_load(nxt, lane, vn, gn); }
                p0_emit(cur, lane, v, gv, scr);
                if (!more) break;
                cur = nxt; it = itn;
#pragma unroll
                for (int i = 0; i < 16; ++i) { v[i] = vn[i]; gv[i] = gn[i]; }
            }
        }
        { const float* x = (const float*)a.in[0]; bf16_t* xb = (bf16_t*)(ws + WS_XB);
          int row = gw; f32x4 v[8];
          if (row < M) {
            { const f32x4* xr = (const f32x4*)(x + (size_t)row * DM) + lane;
#pragma unroll
              for (int j = 0; j < 8; ++j) v[j] = xr[64 * j]; }
            for (;;) {
                const int rown = row + NGW; const bool more = rown < M; f32x4 vn[8];
                if (more) { const f32x4* xr = (const f32x4*)(x + (size_t)rown * DM) + lane;
#pragma unroll
                    for (int j = 0; j < 8; ++j) vn[j] = xr[64 * j]; }
                float s = 0.f;
#pragma unroll
                for (int j = 0; j < 8; ++j) s += v[j].x * v[j].x + v[j].y * v[j].y + v[j].z * v[j].z + v[j].w * v[j].w;
#pragma unroll
                for (int o = 1; o < 64; o <<= 1) s += __shfl_xor(s, o);
                const float rs = 1.0f / sqrtf(s * (1.0f / DM) + EPS);
                uint2* o8 = (uint2*)(xb + (size_t)row * DM) + lane;
#pragma unroll
                for (int j = 0; j < 8; ++j) { uint2 w; w.x = pk2(v[j].x * rs, v[j].y * rs); w.y = pk2(v[j].z * rs, v[j].w * rs); o8[64 * j] = w; }
                if (!more) break;
                row = rown;
#pragma unroll
                for (int j = 0; j < 8; ++j) v[j] = vn[j];
            } } }
        { const int* pos = (const int*)a.in[1];
          for (int idx = bx * NTHREADS + tid; idx < M * 16; idx += G * NTHREADS) {
            const int row = idx >> 4, i = idx & 15;
            const float inv_freq = (float)exp(-(double)i / 16.0 * log(500000.0));
            float c, s; sincos_acc((float)pos[row] * inv_freq, c, s);
            ((float*)(ws + WS_ROPE_COS))[idx] = c; ((float*)(ws + WS_ROPE_SIN))[idx] = s; }
          if (bx == 0 && wave == 0) {
            const float* lq1 = (const float*)a.in[6]; const float* lk1 = (const float*)a.in[7]; const float* lq2 = (const float*)a.in[8]; const float* lk2 = (const float*)a.in[9];
            float p = lq1[lane] * lk1[lane] + lq1[lane + 64] * lk1[lane + 64], q = lq2[lane] * lk2[lane] + lq2[lane + 64] * lk2[lane + 64];
#pragma unroll
            for (int o = 1; o < 64; o <<= 1) { p += __shfl_xor(p, o); q += __shfl_xor(q, o); }
            if (lane == 0) ((float*)(ws + WS_MISC))[0] = expf(p) - expf(q) + LAMBDA_INIT; } }
        if (BOTH(0)) GRID_BAR();
    }

    if (IN(1)) REP(1) {
        PHASE_IDS();
#ifdef PROBE_GEMM_NOEPI
        { pg8::Gemm g{(const bf16_t*)(ws + WS_XB), (const bf16_t*)(ws + WS_W1T), M, NQKVG, DM}; pg8::StaticOrder S; S.init(M, NQKVG, G, bx, WGM_BIG); pg8::EpiNull E;
          pg8::gemm_phase<pg8::EpiNull, pg8::StaticOrder, true, PG8_SP2>(lds, g, S, E, tid); }
#endif
        pg8::Gemm g{(const bf16_t*)(ws + WS_XB), (const bf16_t*)(ws + WS_W1T), M, NQKVG, DM}; pg8::StaticOrder S; S.init(M, NQKVG, G, bx, WGM_BIG);
        pg8::EpiQKVG<true, false> E{(bf16_t*)(ws + WS_Q), (bf16_t*)(ws + WS_K), (bf16_t*)(ws + WS_V), (bf16_t*)(ws + WS_G), (const float*)(ws + WS_MISC + 65536),
                                    (const float*)a.in[4], (const float*)a.in[5], (const float*)(ws + WS_ROPE_COS), (const float*)(ws + WS_ROPE_SIN), (LAS float*)(lds + EPI_OFF)};
        pg8::gemm_phase<pg8::EpiQKVG<true, false>, pg8::StaticOrder, true, PG8_SP2>(lds, g, S, E, tid);
        if (BOTH(1)) GROUP_BAR();
    }
    if (IN(2)) REP(2) {
        char* ldsg = (char*)lds_raw;
        const bf16_t* Qb = (const bf16_t*)(ws + WS_Q); const bf16_t* Kb = (const bf16_t*)(ws + WS_K); const bf16_t* Vb = (const bf16_t*)(ws + WS_V);
        const att::EpiDiff epi{(const bf16_t*)(ws + WS_G), (bf16_t*)(ws + WS_AO), (const float*)a.in[10], *(const float*)(ws + WS_MISC)};
        constexpr int NITEMS = 256;
        if (bx < NITEMS) {
            att::Seam S; att::BlockRef cur = diff_ref(bx, 0, Qb, Kb, Vb);
            att::attn_prime2<0>(cur, ldsg, S, wave_s);
            for (int L = bx; L < NITEMS; L += G)
                for (int qsel = 0; qsel < 2; ++qsel) {
                    for (int p = 0; p < 2; ++p) { const int s = qsel * 4 + p;
                        const att::BlockRef nxt = diff_ref(L, s + 1, Qb, Kb, Vb);
                        att::attn_block2<0, att::EpiDiff, false>(cur, nxt, ldsg, S, epi, wave_s); cur = nxt; }
                    for (int p = 2; p < 4; ++p) { const int s = qsel * 4 + p; const bool last_of_item = s == 7, more_item = L + G < NITEMS;
                        const att::BlockRef nxt = !last_of_item ? diff_ref(L, s + 1, Qb, Kb, Vb) : (more_item ? diff_ref(L + G, 0, Qb, Kb, Vb) : cur);
                        att::attn_block2<0, att::EpiDiff, true>(cur, nxt, ldsg, S, epi, wave_s); cur = nxt; }
                }
        }
        if (BOTH(2)) GROUP_BAR();
    }
    if (IN(3)) REP(3) {
        PHASE_IDS();
        pg8::Gemm g{(const bf16_t*)(ws + WS_AO), (const bf16_t*)(ws + WS_W2T), M, DM, DM}; pg8::StaticOrder S; S.init(M, DM, G, bx, WGM_SMALL);
        pg8::EpiResMid E{(const float*)a.in[0], (bf16_t*)(ws + WS_XB), (float*)(ws + WS_SSQP), (LAS float*)(lds + EPI_OFF)};
        pg8::gemm_phase<pg8::EpiResMid, pg8::StaticOrder, true, PG8_SP2>(lds, g, S, E, tid);
        if (BOTH(3)) GROUP_BAR();
    }
    if (IN(4)) REP(4) {
        PHASE_IDS();
        {
            const bf16_t* xb = (const bf16_t*)(ws + WS_XB); const bf16_t* wf = (const bf16_t*)(ws + WS_W3T) + (size_t)NQKVG * DM;
            const float* ssqp = (const float*)(ws + WS_SSQP); float* logf_ = (float*)(ws + WS_LOGF); const float* fb = (const float*)a.in[14];
            LAS float* P = (LAS float*)(lds + EPI_OFF);
            for (int rr = bx; rr < M / 64; rr += G) { const int r0 = (G == 256) ? (rr & 7) * SEQ + (rr >> 3) * 64 : rr * 64;
                const int mt = wave & 3, kh = wave >> 2, ar = lane & 15, kq = lane >> 4;
                const bf16_t* ap = xb + (size_t)(r0 + 16 * mt + ar) * DM + kh * 1024 + 8 * kq; const bf16_t* bp = wf + (size_t)ar * DM + kh * 1024 + 8 * kq;
                f32x4 c = (f32x4){0.f, 0.f, 0.f, 0.f};
#pragma unroll 8
                for (int k = 0; k < 1024; k += 32) c = __builtin_amdgcn_mfma_f32_16x16x32_bf16(*(const bf16x8*)(ap + k), *(const bf16x8*)(bp + k), c, 0, 0, 0);
                if (kh == 1) { *(LAS f32x4*)(P + (mt * 64 + lane) * 4) = c; }
                __syncthreads();
                if (kh == 0) { const f32x4 o = *(const LAS f32x4*)(P + (mt * 64 + lane) * 4); const float b = fb[ar];
#pragma unroll
                    for (int j = 0; j < 4; ++j) { const int row = r0 + 16 * mt + 4 * kq + j;
                        const f32x4 pa = *(const f32x4*)(ssqp + (size_t)row * 8), pb = *(const f32x4*)(ssqp + (size_t)row * 8 + 4);
                        const float rs = 1.0f / sqrtf(((pa[0] + pa[1]) + (pa[2] + pa[3]) + (pb[0] + pb[1]) + (pb[2] + pb[3])) * (1.0f / 2048.f) + EPS);
                        const float z = (c[j] + o[j]) * rs + b;
                        logf_[((size_t)(row >> 11) * 16 + ar) * SEQ + (row & (SEQ - 1))] = fminf(z, 0.f) - log1pf(expf(-fabsf(z))); } }
                __syncthreads();
            }
        }
        pg8::Gemm g{(const bf16_t*)(ws + WS_XB), (const bf16_t*)(ws + WS_W3T), M, NQKVG, DM}; pg8::StaticOrder S; S.init(M, NQKVG, G, bx, WGM_BIG);
        pg8::EpiQKVG<false, true> E{(bf16_t*)(ws + WS_Q), (bf16_t*)(ws + WS_K), (bf16_t*)(ws + WS_V), (bf16_t*)(ws + WS_G), (const float*)(ws + WS_SSQP),
                                    (const float*)a.in[15], (const float*)a.in[16], nullptr, nullptr, (LAS float*)(lds + EPI_OFF)};
        pg8::gemm_phase<pg8::EpiQKVG<false, true>, pg8::StaticOrder, true, PG8_SP2>(lds, g, S, E, tid);
        if (BOTH(4)) GROUP_BAR();
    }
    if (IN(5)) REP(5) {
        char* ldsg = (char*)lds_raw;
        const bf16_t* Qb = (const bf16_t*)(ws + WS_Q); const bf16_t* Kb = (const bf16_t*)(ws + WS_K); const bf16_t* Vb = (const bf16_t*)(ws + WS_V);
        const att::EpiFox epi{(const bf16_t*)(ws + WS_G), (bf16_t*)(ws + WS_AO)};
        constexpr int NITEMS = 512;
        const int* ord = (const int*)(ldsg + att::OFF_SSQ + 1024 + 64);
        fox_setup((const float*)a.in[14], (const float*)a.in[15], (const float*)a.in[16], ldsg, wave_s);
        int L = bx, pass = 0;
        if (L < NITEMS) {
            att::Seam S; att::BlockRef cur = fox_ref(L, 0, ord, Qb, Kb, Vb);
            att::attn_prime2<1>(cur, ldsg, S, wave_s);
            for (;;) {
                const bool more_pass = pass == 0, more_item = L + G < NITEMS, last = !more_pass && !more_item;
                const int Ln = more_pass ? L : (more_item ? L + G : L), passn = more_pass ? 1 : 0;
                const att::BlockRef nxt = last ? cur : fox_ref(Ln, passn, ord, Qb, Kb, Vb);
                if (pass == 0) fox_bias((const float*)(ws + WS_LOGF) + (size_t)((L & 7) * 16 + cur.head) * SEQ, ldsg, wave_s);
                cur.jlo = __builtin_amdgcn_readfirstlane(fox_jlo(cur.P0, ldsg));
                att::attn_block2<1, att::EpiFox>(cur, nxt, ldsg, S, epi, wave_s);
                if (last) break;
                cur = nxt; L = Ln; pass = passn;
            }
        }
        if (BOTH(5)) GROUP_BAR();
    }
    if (IN(6)) {
        PHASE_IDS();
        pg8::Gemm g{(const bf16_t*)(ws + WS_AO), (const bf16_t*)(ws + WS_W4T), M, DM, DM}; pg8::StaticOrder S; S.init(M, DM, G, bx, WGM_SMALL);
        pg8::EpiResOut E{(const bf16_t*)(ws + WS_XB), a.out};
        pg8::gemm_phase<pg8::EpiResOut, pg8::StaticOrder, true, PG8_SP2>(lds, g, S, E, tid);
    }
#undef IN
#undef BOTH
}

static int mk_grid() {
    static int grid = 0;
    if (grid == 0) {
        int dev = 0, cus = 0, per_cu = 0;
        if (hipGetDevice(&dev) != hipSuccess || hipDeviceGetAttribute(&cus, hipDeviceAttributeMultiprocessorCount, dev) != hipSuccess) { fprintf(stderr, "mk: device query failed\n"); grid = -1; return grid; }
        if (hipFuncSetAttribute((const void*)mk_fwd, hipFuncAttributeMaxDynamicSharedMemorySize, LDS_BYTES) != hipSuccess) { fprintf(stderr, "mk: hipFuncSetAttribute failed\n"); grid = -1; return grid; }
        if (hipOccupancyMaxActiveBlocksPerMultiprocessor(&per_cu, (const void*)mk_fwd, NTHREADS, LDS_BYTES) != hipSuccess || per_cu < 1) { fprintf(stderr, "mk: occupancy query says %d\n", per_cu); grid = -1; return grid; }
        (void)hipGetLastError();
        grid = cus;
        fprintf(stderr, "mk: cus %d per_cu %d grid %d\n", cus, per_cu, grid);
    }
    return grid;
}
static void mk_launch(void* const* d_in, void* d_out, void* d_ws, int ph_lo, int ph_hi, int li, hipStream_t stream) {
    const int grid = mk_grid(); if (grid <= 0) return;
    Args a{}; for (int i = 0; i < 18; ++i) a.in[i] = d_in[i];
    a.out = (float*)d_out; a.ws = (unsigned char*)d_ws; a.ph_lo = ph_lo; a.ph_hi = ph_hi; a.li = li;
    void* args[] = {&a};
    hipError_t e = hipLaunchCooperativeKernel((const void*)mk_fwd, dim3(grid), dim3(NTHREADS), args, LDS_BYTES, stream);
    if (e != hipSuccess) fprintf(stderr, "mk: cooperative launch failed: %s\n", hipGetErrorString(e));
}

extern "C" void kernel_launch(void* const* d_in, const int* in_sizes, int n_in, void* d_out, int out_size, void* d_ws, size_t ws_size, hipStream_t stream) {
    if (n_in != 18 || in_sizes[0] != M * DM || out_size != M * DM || ws_size < WS_END) { fprintf(stderr, "kernel_launch: unexpected shapes (n_in %d, in0 %d, out %d, ws %zu)\n", n_in, n_in > 0 ? in_sizes[0] : -1, out_size, ws_size); return; }
    (void)hipMemsetAsync((char*)d_ws + WS_BAR, 0, 4 * XCD_BAR_WORDS * 4, stream);
#ifdef PROBE_PHASE
    mk_launch(d_in, d_out, d_ws, 0, PROBE_PHASE + 1, 0, stream); mk_launch(d_in, d_out, d_ws, PROBE_PHASE, 7, 1, stream);
#else
    mk_launch(d_in, d_out, d_ws, 0, 7, 0, stream);
#endif
}
```

```cpp
#include <hip/hip_runtime.h>
#include <hip/hip_cooperative_groups.h>
#include <cstdio>
#include <cstdint>

typedef unsigned short bf16_t;
typedef short bf16x8 __attribute__((ext_vector_type(8)));
typedef float f32x4 __attribute__((ext_vector_type(4)));

constexpr int NB = 8, SEQ = 2048, DM = 2048, M = NB * SEQ;
constexpr int NQKVG = 8192, NFG = 16;
constexpr float EPS = 1e-6f;
constexpr float LAMBDA_INIT = 0.2f;
constexpr float ATT_SCALE = 0.08838834764831845f;

constexpr size_t MiB = 1u << 20;
constexpr size_t WS_MISC = 0;
constexpr size_t WS_ROPE_COS = 1 * MiB, WS_ROPE_SIN = 2 * MiB, WS_LOGF = 3 * MiB, WS_CUM = 4 * MiB;
constexpr size_t WS_W1T = 8 * MiB, WS_W2T = 40 * MiB, WS_W3T = 48 * MiB, WS_W4T = 81 * MiB;
constexpr size_t WS_XB = 96 * MiB, WS_Q = 160 * MiB, WS_K = 224 * MiB, WS_V = 288 * MiB, WS_G = 352 * MiB, WS_AO = 416 * MiB, WS_END = 480 * MiB;

__device__ __forceinline__ unsigned short f2bf(float f) { unsigned u = __float_as_uint(f); return (unsigned short)((u + 0x7fffu + ((u >> 16) & 1u)) >> 16); }
__device__ __forceinline__ float bf2f(unsigned short h) { return __uint_as_float((unsigned)h << 16); }

__device__ __forceinline__ void sincos_acc(float ang, float& c, float& s) {
    const double a = (double)ang, twopi = 6.283185307179586476925286766559;
    const double r = a - rint(a / twopi) * twopi; const double r2 = r * r;
    double ts = r, tc = 1.0, ss = r, cs = 1.0;
#pragma unroll
    for (int i = 1; i <= 14; ++i) { tc *= -r2 / (double)((2 * i - 1) * (2 * i)); ts *= -r2 / (double)((2 * i) * (2 * i + 1)); cs += tc; ss += ts; }
    c = (float)cs; s = (float)ss;
}

namespace pg8 {
#define PG8_LAS __attribute__((address_space(3)))
typedef unsigned short bf16_t;
typedef short bf16x8 __attribute__((ext_vector_type(8)));
typedef float f32x4 __attribute__((ext_vector_type(4)));
typedef unsigned u32x4 __attribute__((ext_vector_type(4)));
constexpr int BM = 256, BK = 64, HALF = 128, HTB = HALF * BK * 2  , STAGE_BYTES = 8 * HTB, NXCD = 8, WGM = 8;

__host__ __device__ __forceinline__ int lds_byte(int r, int c) { const int st = (r >> 4) * 2 + (c >> 5), rr = r & 15, cc = c & 31, ob = rr * 64 + cc * 2; return st * 1024 + (ob ^ (((ob >> 9) & 1) << 5)); }
__host__ __device__ __forceinline__ void stage_rc(int b, int& R, int& C) { const int st = b / 1024, sb = b % 1024, swz = sb ^ (((sb >> 9) & 1) << 5); R = (st >> 1) * 16 + swz / 64; C = (st & 1) * 32 + (swz % 64) / 2; }
__host__ __device__ __forceinline__ int perm32(int rho) { const int n = rho >> 4, i = rho & 15; return 8 * (i >> 2) + 4 * n + (i & 3); }

struct Unit { int pm, pn; };
struct Gemm { const bf16_t* A; const bf16_t* Bt; int M, N, K; };

struct StaticOrder {
    int nM, nN, nwg, G, c, wgm;
    __host__ __device__ void init(int M, int N, int G_, int c_, int wgm_ = WGM) { nM = M / BM; nN = N / BM; nwg = nM * nN; G = G_; c = c_; wgm = wgm_; }
    __host__ __device__ bool next(int i, Unit& u) const {
        const long L = (long)i * G + c; if (L >= nwg) return false;
        int wgid = (int)L; { const int q = nwg / NXCD, r = nwg % NXCD, xcd = wgid % NXCD, off = wgid / NXCD; wgid = (xcd < r ? xcd * (q + 1) : r * (q + 1) + (xcd - r) * q) + off; }
        const int nig = wgm * nN, gid = wgid / nig, fm = gid * wgm, gsz = (nM - fm) < wgm ? (nM - fm) : wgm;
        u.pm = fm + ((wgid % nig) % gsz); u.pn = (wgid % nig) / gsz; return true;
    }
    __device__ __forceinline__ void a_ready(const Unit&) const {}
    __device__ __forceinline__ void done(const Unit&) const {}
};


__device__ __forceinline__ float sum_xor16(float x) { auto rr = __builtin_amdgcn_permlane16_swap(__float_as_uint(x), __float_as_uint(x), false, false); return __uint_as_float(rr[0]) + __uint_as_float(rr[1]); }
__device__ __forceinline__ float sum_xor32(float x) { auto rr = __builtin_amdgcn_permlane32_swap(__float_as_uint(x), __float_as_uint(x), false, false); return __uint_as_float(rr[0]) + __uint_as_float(rr[1]); }
__device__ __forceinline__ float xchg_xor32(float x, bool lo_half) { auto rr = __builtin_amdgcn_permlane32_swap(__float_as_uint(x), __float_as_uint(x), false, false); return __uint_as_float(lo_half ? rr[1] : rr[0]); }
__device__ __forceinline__ unsigned cvt_pk_bf16(float lo, float hi) { unsigned r; asm volatile("v_cvt_pk_bf16_f32 %0, %1, %2" : "=v"(r) : "v"(lo), "v"(hi)); return r; }
typedef unsigned u32x2 __attribute__((ext_vector_type(2)));
#define PG8_EPI_BARRIER() do { asm volatile("s_waitcnt lgkmcnt(0)" ::: "memory"); __builtin_amdgcn_s_barrier(); asm volatile("" ::: "memory"); } while (0)
template <bool ROPE, bool PARTS> struct EpiQKVG {
    static constexpr bool PERM = true, AFTER_DRAIN = false;
    static constexpr bool RSTD_LDS = PARTS;
    __device__ __forceinline__ const float* rstd_tile(const Unit& u) const { return rstd + (size_t)u.pm * BM * 8; }
    bf16_t* Q; bf16_t* K; bf16_t* V; bf16_t* G;
    const float* rstd;
    const float* qg; const float* kg; const float* rcos; const float* rsin;
    PG8_LAS float* P;
    __device__ __forceinline__ void operator()(f32x4 (&acc)[2][2][4][2], const Unit& u, int wr, int wc, int fr, int fq) const {
        const int sec = u.pn >> 3, hc = (u.pn & 7) * 256, rl0 = wr * 64 + fr;
#pragma unroll
        for (int ai = 0; ai < 2; ++ai)
#pragma unroll
            for (int m = 0; m < 4; ++m) { if (PARTS) { const int row = u.pm * BM + ai * HALF + rl0 + m * 16;
                (void)row; const f32x4 a = *(const PG8_LAS f32x4*)(P + 2048 + (row - u.pm * BM) * 8), b = *(const PG8_LAS f32x4*)(P + 2048 + (row - u.pm * BM) * 8 + 4);
                const float rs = __builtin_amdgcn_rsqf(((a[0] + a[1]) + (a[2] + a[3]) + (b[0] + b[1]) + (b[2] + b[3])) * (1.0f / 2048.f) + 1e-6f);
#pragma unroll
                for (int bj = 0; bj < 2; ++bj)
#pragma unroll
                    for (int n = 0; n < 2; ++n) acc[ai][bj][m][n] = acc[ai][bj][m][n] * rs; } }
        if (sec <= 1) {
#pragma unroll
            for (int ai = 0; ai < 2; ++ai)
#pragma unroll
                for (int m = 0; m < 4; ++m) { const int rloc = ai * HALF + rl0 + m * 16;
#pragma unroll
                    for (int bj = 0; bj < 2; ++bj) { const f32x4 a = acc[ai][bj][m][0], b = acc[ai][bj][m][1];
                        float ss = (a[0] * a[0] + a[1] * a[1]) + (a[2] * a[2] + a[3] * a[3]) + (b[0] * b[0] + b[1] * b[1]) + (b[2] * b[2] + b[3] * b[3]);
                        ss = sum_xor32(sum_xor16(ss));
                        if (fq == 0) P[rloc * 8 + bj * 4 + wc] = ss; } }
            PG8_EPI_BARRIER();
            const float* gn = (sec == 0 ? qg : kg) + wc * 32 + 8 * fq;
            const float qsc = sec == 0 ? 0.12751743082459868f : 1.0f;
            const f32x4 g0 = *(const f32x4*)gn, g1 = *(const f32x4*)(gn + 4);
            bf16_t* dst = sec == 0 ? Q : K;
#pragma unroll
            for (int ai = 0; ai < 2; ++ai)
#pragma unroll
                for (int m = 0; m < 4; ++m) { const int rloc = ai * HALF + rl0 + m * 16, row = u.pm * BM + rloc;
                    f32x4 c0, c1, s0, s1;
                    if (ROPE && wc == 0) { const float* cp = rcos + (size_t)row * 16 + 8 * (fq & 1); const float* sp = rsin + (size_t)row * 16 + 8 * (fq & 1);
                        c0 = *(const f32x4*)cp; c1 = *(const f32x4*)(cp + 4); s0 = *(const f32x4*)sp; s1 = *(const f32x4*)(sp + 4);
                        if (fq < 2) { s0 = -s0; s1 = -s1; } }
#pragma unroll
                    for (int bj = 0; bj < 2; ++bj) { const f32x4 p4 = *(const PG8_LAS f32x4*)(P + rloc * 8 + bj * 4);
                        const float rh = __builtin_amdgcn_rsqf(((p4[0] + p4[1]) + (p4[2] + p4[3])) * (1.0f / 128.f) + 1e-6f) * qsc;
                        f32x4 v0 = acc[ai][bj][m][0] * rh * g0, v1 = acc[ai][bj][m][1] * rh * g1;
                        if (ROPE && wc == 0) {
#pragma unroll
                            for (int j = 0; j < 4; ++j) { const float p0 = xchg_xor32(v0[j], fq < 2), p1 = xchg_xor32(v1[j], fq < 2);
                                v0[j] = v0[j] * c0[j] + p0 * s0[j]; v1[j] = v1[j] * c1[j] + p1 * s1[j]; } }
                        u32x4 w; w.x = cvt_pk_bf16(v0[0], v0[1]); w.y = cvt_pk_bf16(v0[2], v0[3]); w.z = cvt_pk_bf16(v1[0], v1[1]); w.w = cvt_pk_bf16(v1[2], v1[3]);
                        *(u32x4*)(dst + (size_t)row * 2048 + hc + bj * HALF + wc * 32 + 8 * fq) = w; } }
        } else {
            bf16_t* dst = sec == 2 ? V : G;
#pragma unroll
            for (int ai = 0; ai < 2; ++ai)
#pragma unroll
                for (int m = 0; m < 4; ++m) { const int row = u.pm * BM + ai * HALF + rl0 + m * 16;
#pragma unroll
                    for (int bj = 0; bj < 2; ++bj) { f32x4 v0 = acc[ai][bj][m][0], v1 = acc[ai][bj][m][1];
                        if (sec == 3) {
#pragma unroll
                            for (int j = 0; j < 4; ++j) { v0[j] = v0[j] * __builtin_amdgcn_rcpf(1.0f + __builtin_amdgcn_exp2f(-1.4426950408889634f * v0[j]));
                                                          v1[j] = v1[j] * __builtin_amdgcn_rcpf(1.0f + __builtin_amdgcn_exp2f(-1.4426950408889634f * v1[j])); } }
                        u32x4 w; w.x = cvt_pk_bf16(v0[0], v0[1]); w.y = cvt_pk_bf16(v0[2], v0[3]); w.z = cvt_pk_bf16(v1[0], v1[1]); w.w = cvt_pk_bf16(v1[2], v1[3]);
                        *(u32x4*)(dst + (size_t)row * 2048 + hc + bj * HALF + wc * 32 + 8 * fq) = w; } }
        }
    }
};

struct EpiNull { static constexpr bool PERM = true, AFTER_DRAIN = false, RSTD_LDS = false;
    __device__ __forceinline__ void operator()(f32x4 (&acc)[2][2][4][2], const Unit&, int, int, int, int) const {
#pragma unroll
        for (int ai = 0; ai < 2; ++ai)
#pragma unroll
            for (int bj = 0; bj < 2; ++bj)
#pragma unroll
                for (int m = 0; m < 4; ++m)
#pragma unroll
                    for (int n = 0; n < 2; ++n) asm volatile("" :: "v"(acc[ai][bj][m][n])); } };
struct EpiResMid {
    static constexpr bool PERM = true, AFTER_DRAIN = false, RSTD_LDS = false;
    const float* resid; bf16_t* xb; float* ssqp; PG8_LAS float* P;
    __device__ __forceinline__ void operator()(f32x4 (&acc)[2][2][4][2], const Unit& u, int wr, int wc, int fr, int fq) const {
        const int col0 = u.pn * BM + wc * 32 + 8 * fq, rl0 = wr * 64 + fr;
#pragma unroll
        for (int ai = 0; ai < 2; ++ai)
#pragma unroll
            for (int m = 0; m < 4; ++m) { const int rloc = ai * HALF + rl0 + m * 16; const size_t off = (size_t)(u.pm * BM + rloc) * 2048 + col0; float ss = 0.f;
#pragma unroll
                for (int bj = 0; bj < 2; ++bj) { const u32x4 rr = *(const u32x4*)(xb + off + bj * HALF);
                    const f32x4 r0 = (f32x4){__uint_as_float(rr.x << 16), __uint_as_float(rr.x & 0xffff0000u), __uint_as_float(rr.y << 16), __uint_as_float(rr.y & 0xffff0000u)};
                    const f32x4 r1 = (f32x4){__uint_as_float(rr.z << 16), __uint_as_float(rr.z & 0xffff0000u), __uint_as_float(rr.w << 16), __uint_as_float(rr.w & 0xffff0000u)};
                    const f32x4 o0 = r0 + acc[ai][bj][m][0], o1 = r1 + acc[ai][bj][m][1];
                    ss += ((o0[0] * o0[0] + o0[1] * o0[1]) + (o0[2] * o0[2] + o0[3] * o0[3])) + ((o1[0] * o1[0] + o1[1] * o1[1]) + (o1[2] * o1[2] + o1[3] * o1[3]));
                    u32x4 w; w.x = cvt_pk_bf16(o0[0], o0[1]); w.y = cvt_pk_bf16(o0[2], o0[3]); w.z = cvt_pk_bf16(o1[0], o1[1]); w.w = cvt_pk_bf16(o1[2], o1[3]);
                    *(u32x4*)(xb + off + bj * HALF) = w; }
                ss = sum_xor32(sum_xor16(ss)); if (fq == 0) P[rloc * 4 + wc] = ss;
                if (m & 1) asm volatile("" ::: "memory"); }
        PG8_EPI_BARRIER();
        if (wc == 0 && fq == 0) {
#pragma unroll
            for (int ai = 0; ai < 2; ++ai)
#pragma unroll
                for (int m = 0; m < 4; ++m) { const int rloc = ai * HALF + rl0 + m * 16; const f32x4 p4 = *(const PG8_LAS f32x4*)(P + rloc * 4);
                    ssqp[(size_t)(u.pm * BM + rloc) * 8 + u.pn] = (p4[0] + p4[1]) + (p4[2] + p4[3]); } }
    }
};
struct EpiResOut {
    static constexpr bool PERM = true, AFTER_DRAIN = false, RSTD_LDS = false;
    const bf16_t* xb; float* out;
    __device__ __forceinline__ void operator()(f32x4 (&acc)[2][2][4][2], const Unit& u, int wr, int wc, int fr, int fq) const {
        const int col0 = u.pn * BM + wc * 32 + 8 * fq, rl0 = wr * 64 + fr;
#pragma unroll
        for (int ai = 0; ai < 2; ++ai)
#pragma unroll
            for (int m = 0; m < 4; ++m) { const size_t off = (size_t)(u.pm * BM + ai * HALF + rl0 + m * 16) * 2048 + col0;
#pragma unroll
                for (int bj = 0; bj < 2; ++bj) { const u32x4 r = __builtin_nontemporal_load((const u32x4*)(xb + off + bj * HALF));
                    f32x4 o0 = acc[ai][bj][m][0], o1 = acc[ai][bj][m][1];
                    o0[0] += __uint_as_float(r.x << 16); o0[1] += __uint_as_float(r.x & 0xffff0000u); o0[2] += __uint_as_float(r.y << 16); o0[3] += __uint_as_float(r.y & 0xffff0000u);
                    o1[0] += __uint_as_float(r.z << 16); o1[1] += __uint_as_float(r.z & 0xffff0000u); o1[2] += __uint_as_float(r.w << 16); o1[3] += __uint_as_float(r.w & 0xffff0000u);
                    __builtin_nontemporal_store(o0, (f32x4*)(out + off + bj * HALF)); __builtin_nontemporal_store(o1, (f32x4*)(out + off + bj * HALF + 4)); }
                if (m & 1) asm volatile("" ::: "memory"); }
    }
};

template <class Epi, class Sched, bool ALIGN_EPI = false, bool SP2 = false>
__device__ __forceinline__ void gemm_phase(PG8_LAS unsigned char* lds, const Gemm g, const Sched& S, const Epi& E, const int tid) {
    const int wid = __builtin_amdgcn_readfirstlane(tid >> 6), lane = tid & 63, wr = wid >> 2, wc = wid & 3, fr = lane & 15, fq = lane >> 4;
    const int K = g.K, nt = K / BK;
    unsigned voffA[2], voffB[2];
#pragma unroll
    for (int i = 0; i < 2; ++i) { int R, C; stage_rc(tid * 16 + i * 8192, R, C); const int Rb = Epi::PERM ? ((R & ~31) + perm32(R & 31)) : R;
        voffA[i] = (unsigned)(R * K + C) * 2u; voffB[i] = (unsigned)(Rb * K + C) * 2u; }
    const size_t kstep = (size_t)(BK * 2);
    const size_t hstep = (size_t)HALF * K * 2;
    const size_t tstep = 2 * hstep;
    const unsigned ldsw = (unsigned)wid * 1024u;
    const int aoff = lds_byte(wr * 64 + fr, fq * 8), boff = lds_byte(wc * 32 + fr, fq * 8);
#define PG8_SA(b, h) (((b) * 2 + (h)) * HTB)
#define PG8_SB(b, h) ((4 + (b) * 2 + (h)) * HTB)
#define PG8_STAGE(bufoff, gbase, voff) do { _Pragma("unroll") for (int _i = 0; _i < 2; ++_i) \
        __builtin_amdgcn_global_load_lds((const unsigned*)((const char*)(gbase) + (voff)[_i]), (PG8_LAS unsigned*)(lds + (bufoff) + ldsw + _i * 8192), 16, 0, 0); } while (0)
#define PG8_LDA(dst, b, h) do { _Pragma("unroll") for (int m = 0; m < 4; ++m) _Pragma("unroll") for (int k = 0; k < 2; ++k) dst[m][k] = *(const PG8_LAS bf16x8*)(lds + PG8_SA(b, h) + aoff + m * 2048 + k * 1024); } while (0)
#define PG8_LDB(dst, b, h) do { _Pragma("unroll") for (int n = 0; n < 2; ++n) _Pragma("unroll") for (int k = 0; k < 2; ++k) dst[n][k] = *(const PG8_LAS bf16x8*)(lds + PG8_SB(b, h) + boff + n * 2048 + k * 1024); } while (0)
#define PG8_MMA(ai, bj, At, Bt) do { __builtin_amdgcn_s_setprio(1); _Pragma("unroll") for (int m = 0; m < 4; ++m) _Pragma("unroll") for (int n = 0; n < 2; ++n) _Pragma("unroll") for (int k = 0; k < 2; ++k) \
        acc[ai][bj][m][n] = __builtin_amdgcn_mfma_f32_16x16x32_bf16(Bt[n][k], At[m][k], acc[ai][bj][m][n], 0, 0, 0); __builtin_amdgcn_s_setprio(0); } while (0)
#define PG8_WAIT_V(n) asm volatile("s_waitcnt vmcnt(" #n ")" ::: "memory")
#define PG8_WAIT_L(n) asm volatile("s_waitcnt lgkmcnt(" #n ")" ::: "memory")
#define PG8_BAR __builtin_amdgcn_s_barrier()
#define PG8_SCHED __builtin_amdgcn_sched_barrier(0)
    Unit cur, nxt; int ui = 0;
    if (!S.next(0, cur)) return;
    f32x4 acc[2][2][4][2];
#pragma unroll
    for (int a = 0; a < 2; ++a)
#pragma unroll
        for (int b = 0; b < 2; ++b)
#pragma unroll
            for (int m = 0; m < 4; ++m)
#pragma unroll
                for (int n = 0; n < 2; ++n) acc[a][b][m][n] = (f32x4){0.f, 0.f, 0.f, 0.f};
    bf16x8 At[4][2], B0[2][2], B1[2][2];
    const char* cA = (const char*)g.A + (size_t)cur.pm * tstep; const char* cB = (const char*)g.Bt + (size_t)cur.pn * tstep;
    S.a_ready(cur);
    if constexpr (SP2) {
        PG8_STAGE(PG8_SB(0, 0), cB, voffB); PG8_STAGE(PG8_SB(0, 1), cB + hstep, voffB); PG8_STAGE(PG8_SA(0, 0), cA, voffA); PG8_STAGE(PG8_SA(0, 1), cA + hstep, voffA);
        if (wr == 1) PG8_BAR;
        PG8_WAIT_V(2); PG8_BAR;
        PG8_STAGE(PG8_SB(1, 0), cB + kstep, voffB); PG8_STAGE(PG8_SA(1, 0), cA + kstep, voffA); PG8_STAGE(PG8_SB(1, 1), cB + hstep + kstep, voffB);
        PG8_WAIT_V(6); PG8_BAR;
    } else {
        PG8_STAGE(PG8_SB(0, 0), cB, voffB); PG8_STAGE(PG8_SA(0, 0), cA, voffA); PG8_STAGE(PG8_SB(0, 1), cB + hstep, voffB); PG8_STAGE(PG8_SA(0, 1), cA + hstep, voffA);
        if (wr == 1) PG8_BAR;
        PG8_WAIT_V(4); PG8_BAR;
        PG8_STAGE(PG8_SB(1, 0), cB + kstep, voffB); PG8_STAGE(PG8_SA(1, 0), cA + kstep, voffA); PG8_STAGE(PG8_SB(1, 1), cB + hstep + kstep, voffB);
        PG8_WAIT_V(6); PG8_BAR;
    }
    for (;;) {
        const bool has_next = S.next(ui + 1, nxt);
        const char* nA = has_next ? (const char*)g.A + (size_t)nxt.pm * tstep : cA; const char* nB = has_next ? (const char*)g.Bt + (size_t)nxt.pn * tstep : cB;
        for (int t = 0; t < nt; t += 2) {
            const bool last = (t == nt - 2);
            const char* a1 = cA + (size_t)(t + 1) * kstep;
            const char* a2 = last ? nA : cA + (size_t)(t + 2) * kstep; const char* b2 = last ? nB : cB + (size_t)(t + 2) * kstep;
            const char* a3 = a2 + kstep; const char* b3 = b2 + kstep;
            if (last && has_next) S.a_ready(nxt);
            if constexpr (Epi::RSTD_LDS) { if (t == nt - 4) __builtin_amdgcn_global_load_lds((const unsigned*)(E.rstd_tile(cur) + tid * 4), (PG8_LAS unsigned*)(lds + 139264 + wid * 1024), 16, 0, 0); }
            if constexpr (SP2) {
            PG8_LDB(B0, 0, 0); PG8_LDB(B1, 0, 1); PG8_SCHED; PG8_LDA(At, 0, 0); PG8_STAGE(PG8_SA(1, 1), a1 + hstep, voffA);
            PG8_WAIT_V(8); PG8_WAIT_L(0); PG8_BAR; PG8_MMA(0, 0, At, B0); PG8_MMA(0, 1, At, B1); PG8_BAR; PG8_SCHED;
            PG8_LDA(At, 0, 1); PG8_STAGE(PG8_SB(0, 0), b2, voffB); PG8_STAGE(PG8_SB(0, 1), b2 + hstep, voffB); PG8_STAGE(PG8_SA(0, 0), a2, voffA);
            PG8_WAIT_V(8); PG8_WAIT_L(0); PG8_BAR; PG8_MMA(1, 0, At, B0); PG8_MMA(1, 1, At, B1); PG8_BAR; PG8_SCHED;
            PG8_LDB(B0, 1, 0); PG8_LDB(B1, 1, 1); PG8_SCHED; PG8_LDA(At, 1, 0); PG8_STAGE(PG8_SA(0, 1), a2 + hstep, voffA);
            PG8_WAIT_V(8); PG8_WAIT_L(0); PG8_BAR; PG8_MMA(0, 0, At, B0); PG8_MMA(0, 1, At, B1); PG8_BAR; PG8_SCHED;
            PG8_LDA(At, 1, 1); PG8_STAGE(PG8_SB(1, 0), b3, voffB); PG8_STAGE(PG8_SB(1, 1), b3 + hstep, voffB); PG8_STAGE(PG8_SA(1, 0), a3, voffA);
            PG8_WAIT_V(8); PG8_WAIT_L(0); PG8_BAR; PG8_MMA(1, 0, At, B0); PG8_MMA(1, 1, At, B1); PG8_BAR; PG8_SCHED;
            } else {
            PG8_LDB(B0, 0, 0); PG8_SCHED; PG8_LDA(At, 0, 0); PG8_STAGE(PG8_SA(1, 1), a1 + hstep, voffA);
            PG8_WAIT_L(8); PG8_BAR; PG8_WAIT_L(0); PG8_MMA(0, 0, At, B0); PG8_BAR; PG8_SCHED;
            PG8_LDB(B1, 0, 1); PG8_STAGE(PG8_SB(0, 0), b2, voffB);
            PG8_BAR; PG8_WAIT_L(0); PG8_MMA(0, 1, At, B1); PG8_BAR;
            PG8_LDA(At, 0, 1); PG8_STAGE(PG8_SA(0, 0), a2, voffA);
            PG8_BAR; PG8_WAIT_L(0); PG8_MMA(1, 0, At, B0); PG8_BAR; PG8_SCHED;
            PG8_STAGE(PG8_SB(0, 1), b2 + hstep, voffB);
            PG8_WAIT_V(6); PG8_BAR; PG8_MMA(1, 1, At, B1); PG8_BAR;
            PG8_LDB(B0, 1, 0); PG8_SCHED; PG8_LDA(At, 1, 0); PG8_STAGE(PG8_SA(0, 1), a2 + hstep, voffA);
            PG8_WAIT_L(8); PG8_BAR; PG8_WAIT_L(0); PG8_MMA(0, 0, At, B0); PG8_BAR; PG8_SCHED;
            PG8_LDB(B1, 1, 1); PG8_STAGE(PG8_SB(1, 0), b3, voffB);
            PG8_BAR; PG8_WAIT_L(0); PG8_MMA(0, 1, At, B1); PG8_BAR;
            PG8_LDA(At, 1, 1); PG8_STAGE(PG8_SA(1, 0), a3, voffA);
            PG8_BAR; PG8_WAIT_L(0); PG8_MMA(1, 0, At, B0); PG8_BAR; PG8_SCHED;
            PG8_STAGE(PG8_SB(1, 1), b3 + hstep, voffB);
            PG8_WAIT_V(6); PG8_BAR; PG8_MMA(1, 1, At, B1); PG8_BAR;
            }
        }
        if constexpr (ALIGN_EPI) { if (wr == 0) PG8_BAR; }
        if constexpr (!Epi::AFTER_DRAIN) { E(acc, cur, wr, wc, fr, fq); S.done(cur); }
        if (!has_next) break;
#pragma unroll
        for (int a = 0; a < 2; ++a)
#pragma unroll
            for (int b = 0; b < 2; ++b)
#pragma unroll
                for (int m = 0; m < 4; ++m)
#pragma unroll
                    for (int n = 0; n < 2; ++n) acc[a][b][m][n] = (f32x4){0.f, 0.f, 0.f, 0.f};
        cur = nxt; cA = nA; cB = nB; ++ui;
        if constexpr (ALIGN_EPI) { if (wr == 1) PG8_BAR; }
    }
    PG8_WAIT_V(0);
    if constexpr (!ALIGN_EPI) { if (wr == 0) PG8_BAR; }
    PG8_BAR;
    if constexpr (Epi::AFTER_DRAIN) { E.fused(acc, cur, wr, wc, fr, fq, lds, wid, lane); S.done(cur); }
#undef PG8_SA
#undef PG8_SB
#undef PG8_STAGE
#undef PG8_LDA
#undef PG8_LDB
#undef PG8_MMA
#undef PG8_WAIT_V
#undef PG8_WAIT_L
#undef PG8_BAR
#undef PG8_SCHED
}
}

namespace cg = cooperative_groups;
#ifndef WGM_BIG
#define WGM_BIG 4
#endif
#ifndef WGM_SMALL
#define WGM_SMALL 4
#endif
static_assert(8 % WGM_BIG == 0 && 8 % WGM_SMALL == 0, "the group barriers need every batch's 8 row tiles inside one XCD-chunk of the GEMM tile order: the group size must divide 8");
#ifndef PG8_SP2
#define PG8_SP2 true
#endif
#define LAS __attribute__((address_space(3)))
constexpr int NWAVES = 8, NTHREADS = NWAVES * 64;
constexpr int RING_BYTES = 131072;
constexpr int EPI_OFF = RING_BYTES;
constexpr int LDS_BYTES = 148480;
constexpr size_t WS_SSQP = 5 * MiB;

__device__ __forceinline__ int lane_id_v() { int l; asm volatile("v_mbcnt_lo_u32_b32 %0, -1, 0\n\tv_mbcnt_hi_u32_b32 %0, -1, %0" : "=v"(l)); return l; }
__device__ __forceinline__ int make_tid(const int wave_s) { return wave_s * 64 + lane_id_v(); }
namespace att {
typedef short s16x4 __attribute__((ext_vector_type(4)));
typedef float f32x16 __attribute__((ext_vector_type(16)));
typedef unsigned u32x4 __attribute__((ext_vector_type(4)));
constexpr int D = 128, PITCH = 2048, NW = 8, QBLK = 32, KVBLK = 64, QB = NW * QBLK;
constexpr int SHM_V = KVBLK * D * 2, SHM_K = KVBLK * D * 2;
constexpr int OFF_WS = 2 * SHM_V + 2 * SHM_K;
constexpr int OFF_BIAS = OFF_WS + NW * 64 * 4;
constexpr int OFF_SSQ = OFF_BIAS + 2048 * 4;
constexpr int OFF_STG = OFF_SSQ + NW * 32 * 4 + 256;
constexpr int LDS_END = OFF_STG + NW * 8192;
static_assert(OFF_STG % 16 == 0 && LDS_END <= LDS_BYTES, "attention LDS map");
constexpr float SCALE = 0.08838834764831845f, THR = 8.f, LOG2E = 1.4426950408889634f;
#define KSWZ(row, colB) ((row) * 256 + ((colB) ^ (((row) & 15) << 4)))
#define SBAR() __builtin_amdgcn_sched_barrier(0)
__device__ __forceinline__ int v_st(int k, int c) { const int kk = k; return ((kk >> 3) * 4 + (c >> 5)) * 512 + ((kk & 7) * 32 + (c & 31)) * 2; }
__device__ __forceinline__ int v_rd_base(int lane) { return ((lane & 3) << 3) | (((lane >> 2) & 3) << 6) | (((lane >> 4) & 1) << 5) | (((lane >> 5) & 1) << 8); }
constexpr int v_rd_off(int d0, int ks, int half) { return d0 * 512 + ks * 4096 + half * 2048; }
__device__ __forceinline__ int crow(int r, int hi) { return (r & 3) + 8 * (r >> 2) + 4 * hi; }
__device__ __forceinline__ unsigned cvtpk(float lo, float hi) { unsigned r; asm volatile("v_cvt_pk_bf16_f32 %0, %1, %2" : "=v"(r) : "v"(lo), "v"(hi)); return r; }
__device__ __forceinline__ void mask_tile(f32x16& p0, f32x16& p1, int dq) {
    const float NEG = -__builtin_inff();
#pragma unroll
    for (int r = 0; r < 16; ++r) { const int c = (r & 3) + 8 * (r >> 2); if (dq - c < 0) p0[r] = NEG; if (dq - c - 32 < 0) p1[r] = NEG; }
}
__device__ __forceinline__ void partialSM(f32x16& p0, f32x16& p1, float& m_reg, float& mn, float& alpha) {
    float pmax = p0[0]; for (int r = 1; r < 16; ++r) pmax = fmaxf(pmax, p0[r]); for (int r = 0; r < 16; ++r) pmax = fmaxf(pmax, p1[r]);
    { auto rr = __builtin_amdgcn_permlane32_swap(__float_as_uint(pmax), __float_as_uint(pmax), false, false);
      pmax = fmaxf(__uint_as_float(rr[0]), __uint_as_float(rr[1])); }
    if (__builtin_expect(__all((pmax - m_reg) <= THR * LOG2E), 1)) { mn = m_reg; alpha = 1.f; }
    else { mn = fmaxf(m_reg, pmax); alpha = __builtin_amdgcn_exp2f(m_reg - mn); m_reg = mn; }
    const float mnL = -mn;
    for (int r = 0; r < 16; ++r) p0[r] = p0[r] + mnL; for (int r = 0; r < 16; ++r) p1[r] = p1[r] + mnL;
    for (int r = 0; r < 16; ++r) p0[r] = __builtin_amdgcn_exp2f(p0[r]);
}
__device__ __forceinline__ void finishSM(f32x16& p0, f32x16& p1, float alpha, float& l_reg, bf16x8& pa0, bf16x8& pa1, bf16x8& pa2, bf16x8& pa3) {
    for (int r = 0; r < 16; ++r) p1[r] = __builtin_amdgcn_exp2f(p1[r]);
    SBAR();
    float ps = 0; for (int r = 0; r < 16; ++r) ps += p0[r]; for (int r = 0; r < 16; ++r) ps += p1[r];
    { auto rr = __builtin_amdgcn_permlane32_swap(__float_as_uint(ps), __float_as_uint(ps), false, false);
      ps = __uint_as_float(rr[0]) + __uint_as_float(rr[1]); }
    l_reg = l_reg * alpha + ps;
#define PK4(P, B_, OUT) do { unsigned a0 = cvtpk(P[B_+0], P[B_+1]), a1 = cvtpk(P[B_+2], P[B_+3]);                          \
        unsigned b0 = cvtpk(P[B_+4], P[B_+5]), b1 = cvtpk(P[B_+6], P[B_+7]);                                             \
        u32x4 w = {a0, a1, b0, b1}; OUT = *reinterpret_cast<bf16x8*>(&w); } while (0)
    PK4(p0, 0, pa0); PK4(p0, 8, pa1); PK4(p1, 0, pa2); PK4(p1, 8, pa3); SBAR();
#undef PK4
}
__device__ __forceinline__ void psm_fix(f32x16& p0, f32x16& p1, float mnL) {
    for (int r = 0; r < 16; ++r) p0[r] = p0[r] + mnL; for (int r = 0; r < 16; ++r) p1[r] = p1[r] + mnL;
    for (int r = 0; r < 16; ++r) p0[r] = __builtin_amdgcn_exp2f(p0[r]);
}
__device__ __forceinline__ void fsm_fix(f32x16& p0, f32x16& p1, bf16x8& pa0, bf16x8& pa1, bf16x8& pa2, bf16x8& pa3) {
    for (int r = 0; r < 16; ++r) p1[r] = __builtin_amdgcn_exp2f(p1[r]);
    SBAR();
#define PK4(P, B_, OUT) do { unsigned a0 = cvtpk(P[B_+0], P[B_+1]), a1 = cvtpk(P[B_+2], P[B_+3]);                          \
        unsigned b0 = cvtpk(P[B_+4], P[B_+5]), b1 = cvtpk(P[B_+6], P[B_+7]);                                             \
        u32x4 w = {a0, a1, b0, b1}; OUT = *reinterpret_cast<bf16x8*>(&w); } while (0)
    PK4(p0, 0, pa0); PK4(p0, 8, pa1); PK4(p1, 0, pa2); PK4(p1, 8, pa3); SBAR();
#undef PK4
}
template <bool SUM>
__device__ __forceinline__ void sm_static(f32x16& p0, f32x16& p1, float& l_reg, bf16x8& pa0, bf16x8& pa1, bf16x8& pa2, bf16x8& pa3) {
    for (int r = 0; r < 16; ++r) p0[r] = __builtin_amdgcn_exp2f(p0[r]); for (int r = 0; r < 16; ++r) p1[r] = __builtin_amdgcn_exp2f(p1[r]);
    SBAR();
    if (SUM) { float ps = 0; for (int r = 0; r < 16; ++r) ps += p0[r]; for (int r = 0; r < 16; ++r) ps += p1[r];
        auto rr = __builtin_amdgcn_permlane32_swap(__float_as_uint(ps), __float_as_uint(ps), false, false);
        l_reg += __uint_as_float(rr[0]) + __uint_as_float(rr[1]); }
#define PK4(P, B_, OUT) do { unsigned a0 = cvtpk(P[B_+0], P[B_+1]), a1 = cvtpk(P[B_+2], P[B_+3]);                          \
        unsigned b0 = cvtpk(P[B_+4], P[B_+5]), b1 = cvtpk(P[B_+6], P[B_+7]);                                             \
        u32x4 w = {a0, a1, b0, b1}; OUT = *reinterpret_cast<bf16x8*>(&w); } while (0)
    PK4(p0, 0, pa0); PK4(p0, 8, pa1); PK4(p1, 0, pa2); PK4(p1, 8, pa3); SBAR();
#undef PK4
}
struct BlockRef { const bf16_t* Q; const bf16_t* K; const bf16_t* V; int P0; int row0; int head; int step; int jlo; };
struct Seam { bf16x8 qr[8]; bf16x8 st_v0, st_v1, st_k0, st_k1; };
#define ROW(p, k0, rr) ((p) + (size_t)((k0) + (rr)) * PITCH + sc)
#define VMW() asm volatile("s_waitcnt vmcnt(0)" ::: "memory")
#define VMWN(n) asm volatile("s_waitcnt vmcnt(%0)" :: "i"(n) : "memory")
template <int MODE>
__device__ __forceinline__ void attn_prime2(const BlockRef& cur, char* lds, Seam& S, const int wave_s) {
    const int tid = make_tid(wave_s); const int wid = __builtin_amdgcn_readfirstlane(tid >> 6), lane = tid & 63, r32 = lane & 31, hi = lane >> 5;
    const int sr = tid >> 4, sc = (tid & 15) * 8, kws = KSWZ(sr, sc * 2); char* K_lds = lds + 2 * SHM_V;
    for (int d0 = 0; d0 < 8; ++d0) S.qr[d0] = *(const bf16x8*)(cur.Q + (size_t)(wid * QBLK + r32) * PITCH + d0 * 16 + hi * 8);
    const int kb0 = MODE == 1 ? cur.P0 + 3 * KVBLK : 0, kb1 = MODE == 1 ? cur.P0 + 2 * KVBLK : KVBLK;
    const bf16x8 ka = *(const bf16x8*)ROW(cur.K, kb0, sr), kb = *(const bf16x8*)ROW(cur.K, kb0, 32 + sr);
    S.st_k0 = *(const bf16x8*)ROW(cur.K, kb1, sr); S.st_k1 = *(const bf16x8*)ROW(cur.K, kb1, 32 + sr);
    S.st_v0 = *(const bf16x8*)ROW(cur.V, kb0, sr); S.st_v1 = *(const bf16x8*)ROW(cur.V, kb0, 32 + sr);
    *(bf16x8*)(K_lds + kws) = ka; *(bf16x8*)(K_lds + kws + 32 * 256) = kb;
    __syncthreads();
}
template <int MODE, class Epi, bool FIXM = false, bool STAT = false>
__device__ __forceinline__ void attn_block2(const BlockRef& cur, const BlockRef& nxt, char* lds, Seam& S, const Epi& epi, const int wave_s) {
    constexpr bool BIAS = MODE == 1;
    const int tid = make_tid(wave_s); const int wid = __builtin_amdgcn_readfirstlane(tid >> 6), lane = tid & 63, r32 = lane & 31, hi = lane >> 5;
    const int grp = wave_s >> 2;
    const int NTF = cur.P0 / KVBLK + 4, NT = NTF - (MODE == 1 ? cur.jlo : 0);
    const int NTFn = nxt.P0 / KVBLK + 4;
    const int qlo = cur.P0 + wid * QBLK;
    const int qlimw = MODE == 0 ? (qlo | 63) : qlo;
    const int qlast = MODE == 0 ? (qlo | 63) : qlo + QBLK - 1;
    const int qm = (MODE == 0 ? (qlo | 63) : qlo + r32) - 4 * hi;
    char* V_lds = lds; char* K_lds = lds + 2 * SHM_V;
    float* ws = (float*)(lds + OFF_WS) + wid * 64; float* li_l = ws, * al_l = ws + 32;
    const float* btab = (const float*)(lds + OFF_BIAS) + 4 * hi;
    float m_reg = -1e30f, l_reg = 0; f32x16 o[4] = {};
    float2* stat = (float2*)(lds + OFF_BIAS) + (wid * 2 + (cur.step & 1)) * 32;
    float mnLf = 0.f; (void)mnLf;
    if constexpr (FIXM) { const float2 ml = stat[r32]; m_reg = ml.x; l_reg = ml.y; mnLf = -ml.x; }
    float rowref = 0.f; if constexpr (MODE == 1) rowref = ((const float*)(lds + OFF_BIAS))[qlo + r32]; (void)rowref;
    const int sr = tid >> 4, sc = (tid & 15) * 8, vst0 = v_st(sr, sc), vst1 = v_st(32 + sr, sc), kws = KSWZ(sr, sc * 2);
    const int vb0 = (int)(uintptr_t)V_lds + v_rd_base(lane);
    const int kbase = (int)(uintptr_t)lds, koff = KSWZ(r32, hi * 16);
    const unsigned lo0 = (unsigned)(sr * PITCH + sc) * 2u, lo1 = lo0 + 32u * PITCH * 2u;
    const bf16_t* Kh = cur.K; const bf16_t* Vh = cur.V;
#define KBASE(t) ((MODE == 1 ? NTF - 1 - (t) : (t)) * KVBLK)
#define KBASEN(t) ((MODE == 1 ? NTFn - 1 - (t) : (t)) * KVBLK)
#define RESC(a) do { if (__any((a) < 1.f)) { if (hi == 0) al_l[r32] = (a); asm volatile("s_waitcnt lgkmcnt(0)" ::: "memory");              \
                     for (int d_ = 0; d_ < 4; ++d_) for (int r = 0; r < 16; ++r) o[d_][r] *= al_l[crow(r, hi)]; } } while (0)
#define MASKT(P0_, P1_, t) do { const int kb_ = KBASE(t); if (kb_ + KVBLK - 1 > qlimw) { asm volatile("; mask tile"); mask_tile(P0_, P1_, qm - kb_); } } while (0)
#define BAR() do { asm volatile("s_waitcnt lgkmcnt(0)" ::: "memory"); __builtin_amdgcn_s_barrier(); asm volatile("" ::: "memory"); } while (0)
#define LGK(n) asm volatile("s_waitcnt lgkmcnt(%0)" :: "i"(n) : "memory")
    int jw = 0;
#define LDPAIR(Kp, kk, Vp, vk) do { const char* kq_ = (const char*)((Kp) + (size_t)(kk) * PITCH); const char* vq_ = (const char*)((Vp) + (size_t)(vk) * PITCH);   \
                                    S.st_k0 = *(const bf16x8*)(kq_ + lo0); S.st_k1 = *(const bf16x8*)(kq_ + lo1);                                                    \
                                    S.st_v0 = *(const bf16x8*)(vq_ + lo0); S.st_v1 = *(const bf16x8*)(vq_ + lo1); } while (0)
#define WSTEP() do { if (jw < NT) { VMW();                                                                                                  \
            char* kd_ = K_lds + ((jw + 1) & 1) * SHM_K + kws; char* vd_ = V_lds + (jw & 1) * SHM_V;                                            \
            *(bf16x8*)(kd_) = S.st_k0; *(bf16x8*)(kd_ + 32 * 256) = S.st_k1; *(bf16x8*)(vd_ + vst0) = S.st_v0; *(bf16x8*)(vd_ + vst1) = S.st_v1; \
            asm volatile("" ::: "memory");                                                                                                    \
            const int jn_ = jw + 1;                                                                                                           \
            if (jn_ < NT) { const bool in_ = jn_ + 1 < NT; const bf16_t* kp_ = in_ ? Kh : nxt.K; const int kk_ = in_ ? KBASE(jn_ + 1) : KBASEN(0); \
                            LDPAIR(kp_, kk_, Vh, KBASE(jn_)); }                                                                               \
            else { LDPAIR(nxt.K, KBASEN(1), nxt.V, KBASEN(0)); } }                                                                            \
        ++jw; } while (0)
    f32x16 pX0, pX1; float mnX = 0.f, alX = 1.f; bf16x8 pa0, pa1, pa2, pa3; (void)mnX;
#define TRRD(dst, off) asm volatile("ds_read_b64_tr_b16 %0, %1 offset:%2" : "=&v"(dst) : "v"(vb0), "i"(off) : "memory")
#define KRD(dst, ad, off) asm volatile("ds_read_b128 %0, %1 offset:%2" : "=&v"(dst) : "v"(ad), "i"(off) : "memory")
#define PVRD(i, VB, k) do { constexpr int b_ = (VB) * SHM_V + ((k) >> 2) * 512 + ((k) & 3) * 4096; TRRD(L##i, b_); TRRD(H##i, b_ + 2048); } while (0)
#define PVMM(i, k, PA) o[(k) >> 2] = __builtin_amdgcn_mfma_f32_32x32x16_bf16(PA, (bf16x8){L##i[0], L##i[1], L##i[2], L##i[3], H##i[0], H##i[1], H##i[2], H##i[3]}, o[(k) >> 2], 0, 0, 0)
#define KRD1(i, KB, q) do { const int a_ = kbase + (koff ^ (((q) >> 1) << 5)); KRD(K##i, a_, 2 * SHM_V + (KB) * SHM_K + ((q) & 1) * 8192); } while (0)
#define QKMM(i, q) do { if ((q) & 1) pX1 = __builtin_amdgcn_mfma_f32_32x32x16_bf16(K##i, S.qr[(q) >> 1], pX1, 0, 0, 0); else pX0 = __builtin_amdgcn_mfma_f32_32x32x16_bf16(K##i, S.qr[(q) >> 1], pX0, 0, 0, 0); } while (0)
#define M_SEC(KB, VB, t, QK_, PV_) do { __builtin_amdgcn_s_setprio(1); s16x4 L0, L1, L2, L3, L4, L5, L6, L7, H0, H1, H2, H3, H4, H5, H6, H7; bf16x8 K0, K1, K2, K3, K4, K5, K6, K7; \
        if (QK_) { if constexpr (BIAS) { const float* bp_ = btab + KBASE(t); \
                       for (int g_ = 0; g_ < 4; ++g_) { const f32x4 a_ = *(const f32x4*)(bp_ + 8 * g_), b_ = *(const f32x4*)(bp_ + 32 + 8 * g_); \
                           pX0[4 * g_] = a_[0] - rowref; pX0[4 * g_ + 1] = a_[1] - rowref; pX0[4 * g_ + 2] = a_[2] - rowref; pX0[4 * g_ + 3] = a_[3] - rowref; \
                           pX1[4 * g_] = b_[0] - rowref; pX1[4 * g_ + 1] = b_[1] - rowref; pX1[4 * g_ + 2] = b_[2] - rowref; pX1[4 * g_ + 3] = b_[3] - rowref; } \
                       asm volatile("" : "+v"(pX0), "+v"(pX1)); } \
                   else { pX0 = f32x16{}; pX1 = f32x16{}; } SBAR(); } \
        if (PV_) { PVRD(0, VB, 0); PVRD(1, VB, 1); PVRD(2, VB, 2); PVRD(3, VB, 3); PVRD(4, VB, 4); PVRD(5, VB, 5); PVRD(6, VB, 6); PVRD(7, VB, 7); SBAR(); \
            LGK(14); SBAR(); PVMM(0, 0, pa0); SBAR(); PVRD(0, VB, 8); SBAR(); \
            LGK(14); SBAR(); PVMM(1, 1, pa1); SBAR(); PVRD(1, VB, 9); SBAR(); \
            LGK(14); SBAR(); PVMM(2, 2, pa2); SBAR(); PVRD(2, VB, 10); SBAR(); \
            LGK(14); SBAR(); PVMM(3, 3, pa3); SBAR(); PVRD(3, VB, 11); SBAR(); \
            LGK(14); SBAR(); PVMM(4, 4, pa0); SBAR(); PVRD(4, VB, 12); SBAR(); \
            LGK(14); SBAR(); PVMM(5, 5, pa1); SBAR(); PVRD(5, VB, 13); SBAR(); \
            LGK(14); SBAR(); PVMM(6, 6, pa2); SBAR(); PVRD(6, VB, 14); SBAR(); \
            LGK(14); SBAR(); PVMM(7, 7, pa3); SBAR(); PVRD(7, VB, 15); SBAR(); \
            LGK((QK_) ? 14 : 14); SBAR(); PVMM(0, 8, pa0); SBAR(); if (QK_) { KRD1(0, KB, 0); SBAR(); } \
            LGK((QK_) ? 13 : 12); SBAR(); PVMM(1, 9, pa1); SBAR(); if (QK_) { KRD1(1, KB, 1); SBAR(); } \
            LGK((QK_) ? 12 : 10); SBAR(); PVMM(2, 10, pa2); SBAR(); if (QK_) { KRD1(2, KB, 2); SBAR(); } \
            LGK((QK_) ? 11 : 8); SBAR(); PVMM(3, 11, pa3); SBAR(); if (QK_) { KRD1(3, KB, 3); SBAR(); } \
            LGK((QK_) ? 10 : 6); SBAR(); PVMM(4, 12, pa0); SBAR(); if (QK_) { KRD1(4, KB, 4); SBAR(); } \
            LGK((QK_) ? 9 : 4); SBAR(); PVMM(5, 13, pa1); SBAR(); if (QK_) { KRD1(5, KB, 5); SBAR(); } \
            LGK((QK_) ? 8 : 2); SBAR(); PVMM(6, 14, pa2); SBAR(); if (QK_) { KRD1(6, KB, 6); SBAR(); } \
            LGK((QK_) ? 7 : 0); SBAR(); PVMM(7, 15, pa3); SBAR(); if (QK_) { KRD1(7, KB, 7); SBAR(); } \
        } else if (QK_) { KRD1(0, KB, 0); KRD1(1, KB, 1); KRD1(2, KB, 2); KRD1(3, KB, 3); KRD1(4, KB, 4); KRD1(5, KB, 5); KRD1(6, KB, 6); KRD1(7, KB, 7); SBAR(); } \
        if (QK_) { \
            LGK(7); SBAR(); QKMM(0, 0); SBAR(); KRD1(0, KB, 8); SBAR(); \
            LGK(7); SBAR(); QKMM(1, 1); SBAR(); KRD1(1, KB, 9); SBAR(); \
            LGK(7); SBAR(); QKMM(2, 2); SBAR(); KRD1(2, KB, 10); SBAR(); \
            LGK(7); SBAR(); QKMM(3, 3); SBAR(); KRD1(3, KB, 11); SBAR(); \
            LGK(7); SBAR(); QKMM(4, 4); SBAR(); KRD1(4, KB, 12); SBAR(); \
            LGK(7); SBAR(); QKMM(5, 5); SBAR(); KRD1(5, KB, 13); SBAR(); \
            LGK(7); SBAR(); QKMM(6, 6); SBAR(); KRD1(6, KB, 14); SBAR(); \
            LGK(7); SBAR(); QKMM(7, 7); SBAR(); KRD1(7, KB, 15); SBAR(); \
            LGK(7); SBAR(); QKMM(0, 8); SBAR(); \
            LGK(6); SBAR(); QKMM(1, 9); SBAR(); \
            LGK(5); SBAR(); QKMM(2, 10); SBAR(); \
            LGK(4); SBAR(); QKMM(3, 11); SBAR(); \
            LGK(3); SBAR(); QKMM(4, 12); SBAR(); \
            LGK(2); SBAR(); QKMM(5, 13); SBAR(); \
            LGK(1); SBAR(); QKMM(6, 14); SBAR(); \
            LGK(0); SBAR(); QKMM(7, 15); SBAR(); \
        } __builtin_amdgcn_s_setprio(0); } while (0)
#define V_SEC(t) do { if (STAT && KBASE(t) > qlast) { asm volatile("; fully masked tile"); const bf16x8 z_ = {0, 0, 0, 0, 0, 0, 0, 0}; pa0 = z_; pa1 = z_; pa2 = z_; pa3 = z_; } else { MASKT(pX0, pX1, t);                                                                                                        \
        if constexpr (STAT) { sm_static<!FIXM>(pX0, pX1, l_reg, pa0, pa1, pa2, pa3); }                                                          \
        else if constexpr (FIXM) { psm_fix(pX0, pX1, mnLf); fsm_fix(pX0, pX1, pa0, pa1, pa2, pa3); }                                             \
        else { partialSM(pX0, pX1, m_reg, mnX, alX); finishSM(pX0, pX1, alX, l_reg, pa0, pa1, pa2, pa3); RESC(alX); }                            \
        } SBAR(); WSTEP(); } while (0)
    if (grp) { WSTEP(); BAR(); }
    M_SEC(0, 0, 0, true, false); BAR();
    V_SEC(0); BAR();
    for (int t = 1; t + 1 < NT; t += 2) {
        M_SEC(1, 0, t, true, true); BAR();
        V_SEC(t); BAR();
        M_SEC(0, 1, t + 1, true, true); BAR();
        V_SEC(t + 1); BAR();
    }
    M_SEC(1, 0, NT - 1, true, true); BAR();
    V_SEC(NT - 1);
#pragma unroll
    for (int d0 = 0; d0 < 8; ++d0) S.qr[d0] = *(const bf16x8*)(nxt.Q + (size_t)(wid * QBLK + r32) * PITCH + d0 * 16 + hi * 8);
    f32x16 tp[2]; epi.prefetch(tp, cur, wid, lane);
    BAR();
    M_SEC(0, 1, NT, false, true);
    if (!grp) BAR();
    int lane_e = lane; asm volatile("" : "+v"(lane_e));
    if constexpr (MODE == 0 && !FIXM) { if (hi == 0) stat[r32] = make_float2(m_reg, l_reg); }
    if (hi == 0) li_l[r32] = l_reg; asm volatile("s_waitcnt lgkmcnt(0)" ::: "memory");
#pragma unroll
    for (int r = 0; r < 16; ++r) { const float rl = __builtin_amdgcn_rcpf(li_l[crow(r, hi)]);
#pragma unroll
        for (int d0 = 0; d0 < 4; ++d0) o[d0][r] *= rl; }
    epi(o, tp, cur, lds, wid, lane_e);
    __syncthreads();
#undef KBASE
#undef KBASEN
#undef RESC
#undef MASKT
#undef BAR
#undef LGK
#undef LDPAIR
#undef WSTEP
#undef TRRD
#undef KRD
#undef PVRD
#undef PVMM
#undef KRD1
#undef QKMM
#undef M_SEC
#undef V_SEC
}
#undef ROW
#undef VMW
#undef VMWN
__device__ __forceinline__ void tile_load8(u32x4* dst, const bf16_t* __restrict__ src, int lane, unsigned rowbase, int colbase) {
    const int c8 = (lane & 7) * 8; const unsigned off0 = (rowbase + (unsigned)(lane >> 3)) * (unsigned)PITCH + (unsigned)(colbase + c8);
#pragma unroll
    for (int hh = 0; hh < 2; ++hh)
#pragma unroll
        for (int i = 0; i < 4; ++i) dst[hh * 4 + i] = __builtin_nontemporal_load((const u32x4*)(src + off0 + (unsigned)(8 * i) * PITCH + hh * 64));
}
template <int SM>
__device__ __forceinline__ void store_tile(const f32x16* val, char* lds, int wid, int lane, const bf16_t* __restrict__ gate, bf16_t* __restrict__ dst, unsigned rowbase  , int colbase, const float* __restrict__ colscale, const float* rowscale  , const u32x4* gpre = nullptr  ) {
    const int r32 = lane & 31, hi = lane >> 5; float* stg = (float*)(lds + OFF_STG) + wid * 2048;
    const int c8 = (lane & 7) * 8; const unsigned off0 = (rowbase + (unsigned)(lane >> 3)) * (unsigned)PITCH + (unsigned)(colbase + c8);
    u32x4 g[2][4];
    if (SM >= 1) {
#pragma unroll
        for (int hh = 0; hh < 2; ++hh)
#pragma unroll
            for (int i = 0; i < 4; ++i) g[hh][i] = gpre ? gpre[hh * 4 + i] : __builtin_nontemporal_load((const u32x4*)(gate + off0 + (unsigned)(8 * i) * PITCH + hh * 64)); }
#pragma unroll
    for (int hh = 0; hh < 2; ++hh) {
#pragma unroll
        for (int r = 0; r < 16; ++r) { const int row = crow(r, hi); stg[row * 64 + r32] = val[2 * hh][r]; stg[row * 64 + 32 + r32] = val[2 * hh + 1][r]; }
        asm volatile("s_waitcnt lgkmcnt(0)" ::: "memory");
        f32x4 cs0 = (f32x4){1.f, 1.f, 1.f, 1.f}, cs1 = cs0; if (SM == 2) { cs0 = *(const f32x4*)(colscale + hh * 64 + c8); cs1 = *(const f32x4*)(colscale + hh * 64 + c8 + 4); }
#pragma unroll
        for (int i = 0; i < 4; ++i) { const int row = 8 * i + (lane >> 3); f32x4 v0 = *(const f32x4*)(stg + row * 64 + c8), v1 = *(const f32x4*)(stg + row * 64 + c8 + 4);
            if (SM == 2) { const float rsc = rowscale[row]; v0 = v0 * rsc * cs0; v1 = v1 * rsc * cs1; }
            if (SM >= 1) { const u32x4 gg = g[hh][i];
                v0[0] *= __uint_as_float(gg.x << 16); v0[1] *= __uint_as_float(gg.x & 0xffff0000u); v0[2] *= __uint_as_float(gg.y << 16); v0[3] *= __uint_as_float(gg.y & 0xffff0000u);
                v1[0] *= __uint_as_float(gg.z << 16); v1[1] *= __uint_as_float(gg.z & 0xffff0000u); v1[2] *= __uint_as_float(gg.w << 16); v1[3] *= __uint_as_float(gg.w & 0xffff0000u); }
            u32x4 w; w.x = cvtpk(v0[0], v0[1]); w.y = cvtpk(v0[2], v0[3]); w.z = cvtpk(v1[0], v1[1]); w.w = cvtpk(v1[2], v1[3]);
            *(u32x4*)(dst + off0 + (unsigned)(8 * i) * PITCH + hh * 64) = w; }
        asm volatile("s_waitcnt lgkmcnt(0)" ::: "memory");
    }
}
__device__ __forceinline__ void rescale_rows(char* lds, int wid, int lane, const bf16_t* __restrict__ gate, bf16_t* dst, unsigned rowbase, int colbase, const float* __restrict__ colscale, const float* rowscale, const u32x4* apre = nullptr) {
    const int c8 = (lane & 7) * 8; const unsigned off0 = (rowbase + (unsigned)(lane >> 3)) * (unsigned)PITCH + (unsigned)(colbase + c8);
    u32x4 a[2][4], g[2][4];
#pragma unroll
    for (int hh = 0; hh < 2; ++hh)
#pragma unroll
        for (int i = 0; i < 4; ++i) { a[hh][i] = apre ? apre[hh * 4 + i] : *(const u32x4*)(dst + off0 + (unsigned)(8 * i) * PITCH + hh * 64); g[hh][i] = __builtin_nontemporal_load((const u32x4*)(gate + off0 + (unsigned)(8 * i) * PITCH + hh * 64)); }
#pragma unroll
    for (int hh = 0; hh < 2; ++hh) { const f32x4 cs0 = *(const f32x4*)(colscale + hh * 64 + c8), cs1 = *(const f32x4*)(colscale + hh * 64 + c8 + 4);
#pragma unroll
        for (int i = 0; i < 4; ++i) { const float rsc = rowscale[8 * i + (lane >> 3)]; const u32x4 aa = a[hh][i], gg = g[hh][i];
#define RS2(A_, G_, C0_, C1_) cvtpk(__uint_as_float((A_) << 16) * rsc * (C0_) * __uint_as_float((G_) << 16), __uint_as_float((A_) & 0xffff0000u) * rsc * (C1_) * __uint_as_float((G_) & 0xffff0000u))
            u32x4 w; w.x = RS2(aa.x, gg.x, cs0[0], cs0[1]); w.y = RS2(aa.y, gg.y, cs0[2], cs0[3]); w.z = RS2(aa.z, gg.z, cs1[0], cs1[1]); w.w = RS2(aa.w, gg.w, cs1[2], cs1[3]);
#undef RS2
            *(u32x4*)(dst + off0 + (unsigned)(8 * i) * PITCH + hh * 64) = w; } }
}
struct EpiFox { const bf16_t* G; bf16_t* AO;
    __device__ __forceinline__ void prefetch(f32x16* tp, const BlockRef& cur, int wid, int lane) const { tile_load8((u32x4*)tp, G, lane, (unsigned)(cur.row0 + wid * QBLK), cur.head * 128); }
    __device__ __forceinline__ void operator()(f32x16* o, f32x16* tp, const BlockRef& cur, char* lds, int wid, int lane) const {
        store_tile<1>(o, lds, wid, lane, G, AO, (unsigned)(cur.row0 + wid * QBLK), cur.head * 128, nullptr, nullptr, (const u32x4*)tp); } };

struct EpiDiff { const bf16_t* G; bf16_t* AO; const float* gsub; float lam;
    __device__ __forceinline__ void prefetch(f32x16*, const BlockRef&, int, int) const {}
    __device__ __forceinline__ void operator()(f32x16* o, f32x16* tp, const BlockRef& cur, char* lds, int wid, int lane) const {
        const int r32 = lane & 31, hi = lane >> 5; const int step = cur.step;
        u32x4* sA = (u32x4*)(lds + OFF_STG + wid * 8192) + lane;
        float* ssq_l = (float*)(lds + OFF_SSQ) + wid * 32;
        const unsigned rowbase = (unsigned)(cur.row0 + wid * QBLK);
        if ((step & 1) == 0) {
#pragma unroll
            for (int k = 0; k < 8; ++k) { u32x4 w; w.x = cvtpk(o[0][2 * k], o[1][2 * k]); w.y = cvtpk(o[2][2 * k], o[3][2 * k]); w.z = cvtpk(o[0][2 * k + 1], o[1][2 * k + 1]); w.w = cvtpk(o[2][2 * k + 1], o[3][2 * k + 1]); sA[k * 64] = w; }
        } else {
            const bool fin = step == 3;
            float pr[16], pv_[16];
#pragma unroll
            for (int k = 0; k < 8; ++k) { const u32x4 w = sA[k * 64];
#pragma unroll
                for (int e = 0; e < 2; ++e) { const int r = 2 * k + e; const unsigned w0 = e ? w.z : w.x, w1 = e ? w.w : w.y;
                    const float d0_ = __uint_as_float(w0 << 16) - lam * o[0][r], d1_ = __uint_as_float(w0 & 0xffff0000u) - lam * o[1][r];
                    const float d2_ = __uint_as_float(w1 << 16) - lam * o[2][r], d3_ = __uint_as_float(w1 & 0xffff0000u) - lam * o[3][r];
                    o[0][r] = d0_; o[1][r] = d1_; o[2][r] = d2_; o[3][r] = d3_;
                    pr[r] = (d0_ * d0_ + d1_ * d1_) + (d2_ * d2_ + d3_ * d3_); } }
#define DPP_ADD(ctrl, rmask) _Pragma("unroll") for (int r = 0; r < 16; ++r) pr[r] += __int_as_float(__builtin_amdgcn_update_dpp(0, __float_as_int(pr[r]), ctrl, rmask, 0xF, false))
            DPP_ADD(0xB1, 0xF); DPP_ADD(0x4E, 0xF); DPP_ADD(0x141, 0xF); DPP_ADD(0x140, 0xF); DPP_ADD(0x142, 0xA);
#undef DPP_ADD
#pragma unroll
            for (int r = 0; r < 16; ++r) pv_[r] = ssq_l[crow(r, hi)];
            asm volatile("s_waitcnt lgkmcnt(0)" ::: "memory");
#pragma unroll
            for (int r = 0; r < 16; ++r) { const float val = fin ? 0.8f * __builtin_amdgcn_rsqf((pr[r] + pv_[r]) * (1.0f / 256.f) + 1e-6f) : pr[r];
                if (r32 == 31) ssq_l[crow(r, hi)] = val; }
            asm volatile("s_waitcnt lgkmcnt(0)" ::: "memory");
            if (!fin) store_tile<0>(o, lds, wid, lane, nullptr, AO, rowbase, cur.head * 256, nullptr, nullptr);
            else { store_tile<2>(o, lds, wid, lane, G, AO, rowbase, cur.head * 256 + 128, gsub + 128, ssq_l);
                   rescale_rows(lds, wid, lane, G, AO, rowbase, cur.head * 256, gsub, ssq_l); }
        }
    } };
#undef KSWZ
#undef SBAR
}


__device__ __forceinline__ att::BlockRef diff_ref(int L, int s, const bf16_t* Q, const bf16_t* K, const bf16_t* V) {
    const int xcd = L & 7, k = L >> 3, bh = xcd * 8 + (k >> 2), pair = k & 3, b = bh >> 3, h = bh & 7, qb = (s >> 2) ? 7 - pair : pair, pass = s & 3, hh = 2 * h + (pass & 1);
    att::BlockRef r; r.P0 = qb * 256; r.row0 = b * SEQ + qb * 256; r.head = h; r.step = pass; r.jlo = 0;
    r.Q = Q + (size_t)r.row0 * DM + hh * 128; r.K = K + (size_t)b * SEQ * DM + hh * 128; r.V = V + (size_t)b * SEQ * DM + h * 256 + (pass >> 1) * 128; return r;
}
__device__ __forceinline__ int fox_head(int L, const int* ord) { const int g = (L >> 3) >> 2; return ord[g < 8 ? g : 23 - g]; }
__device__ __forceinline__ att::BlockRef fox_ref(int L, int pass, const int* ord, const bf16_t* Q, const bf16_t* K, const bf16_t* V) {
    const int b = L & 7, pair = (L >> 3) & 3, h = fox_head(L, ord), qb = pass ? 7 - pair : pair;
    att::BlockRef r; r.P0 = qb * 256; r.row0 = b * SEQ + qb * 256; r.head = h; r.step = pass; r.jlo = 0;
    r.Q = Q + (size_t)r.row0 * DM + h * 128; r.K = K + (size_t)b * SEQ * DM + h * 128; r.V = V + (size_t)b * SEQ * DM + h * 128; return r;
}
__device__ __forceinline__ void fox_setup(const float* __restrict__ fb, const float* __restrict__ gq, const float* __restrict__ gk, char* lds, const int wave_s) {
    const int lane = lane_id_v(); int* ord = (int*)(lds + att::OFF_SSQ + 1024 + 64); float* tr = (float*)(lds + att::OFF_SSQ + 1024 + 128);
    if (wave_s == 0) {
        float mq = fmaxf(fabsf(gq[lane]), fabsf(gq[lane + 64])), mk = fmaxf(fabsf(gk[lane]), fabsf(gk[lane + 64]));
#pragma unroll
        for (int o = 1; o < 64; o <<= 1) { mq = fmaxf(mq, __shfl_xor(mq, o)); mk = fmaxf(mk, __shfl_xor(mk, o)); }
        if (lane < 16) { const float me = fb[lane]; int rank = 0;
#pragma unroll
            for (int j = 0; j < 16; ++j) { const float o = fb[j]; rank += (o < me || (o == me && j < lane)) ? 1 : 0; }
            ord[rank] = lane; }
        if (lane == 0) { const float b2 = 1.01f * 128.0f * mq * mk * att::SCALE * att::LOG2E; tr[0] = 50.0f * att::LOG2E + 2.0f * b2; tr[1] = b2; }
    }
    __syncthreads();
}
__device__ __forceinline__ int fox_jlo(int P0, char* lds) {
    const int lane = lane_id_v(); const float* tab = (const float*)(lds + att::OFF_BIAS); const float thr = tab[P0] - *(const float*)(lds + att::OFF_SSQ + 1024 + 128);
    const bool skip = lane < (P0 >> 6) && tab[(lane & 31) * 64 + 63] < thr;
    return (int)__builtin_popcountll(__ballot(skip)) & ~1;
}
__device__ __forceinline__ void fox_bias(const float* __restrict__ lf, char* lds, const int wave_s) {
    const int tid = make_tid(wave_s);
    float* tab = (float*)(lds + att::OFF_BIAS); float* wt = (float*)(lds + att::OFF_SSQ + 1024);
    const int lane = tid & 63, wave = tid >> 6;
    const f32x4 v = *(const f32x4*)(lf + 4 * tid);
    const float a0 = v[0], a1 = a0 + v[1], a2 = a1 + v[2], a3 = a2 + v[3];
    float tot = a3;
#pragma unroll
    for (int o = 1; o < 64; o <<= 1) { const float t = __int_as_float(__builtin_amdgcn_ds_bpermute((lane >= o ? lane - o : lane) << 2, __float_as_int(tot))); if (lane >= o) tot += t; }
    if (lane == 63) wt[wave] = tot;
    __syncthreads();
    float base = tot - a3;
    for (int w = 0; w < wave; ++w) base += wt[w];
    const float ns = -att::LOG2E;
    *(f32x4*)(tab + 4 * tid) = (f32x4){(base + a0) * ns, (base + a1) * ns, (base + a2) * ns, (base + a3) * ns};
    __syncthreads();
}

#define XB_TMO      128
#define XB_XCNT(j)  (256  + 64 * (j))
#define XB_XSUB(j)  (1280 + 64 * (j))
#define XB_XGEN(j)  (2304 + 64 * (j))
#define XB_TOP      3328
#define XB_TOPGEN   3392
#define XCD_BAR_WORDS 8192
#define GB_CNT(g)   (4096 + 64 * (g))
#define GB_GEN(g)   (4608 + 64 * (g))
#define GB_MASK(g)  (5120 + 64 * (g))
#define GB_NPOST(g) (5632 + 64 * (g))
#define XB_SPIN_CAP (1u << 22)
__device__ __forceinline__ unsigned xb_ld(unsigned* p)              { return __hip_atomic_load(p, __ATOMIC_RELAXED, __HIP_MEMORY_SCOPE_AGENT); }
__device__ __forceinline__ unsigned xb_add(unsigned* p, unsigned v) { return __hip_atomic_fetch_add(p, v, __ATOMIC_RELAXED, __HIP_MEMORY_SCOPE_AGENT); }
__device__ __forceinline__ unsigned xb_xcc_id() { return (unsigned)__builtin_amdgcn_s_getreg((3 << 11) | 20) & 0xFu; }
#define XB_SPIN(cond, bar) do { unsigned _sp = 0; while (cond) { __builtin_amdgcn_s_sleep(1); \
    if ((++_sp & 255u) == 0u) { if (xb_ld(&(bar)[XB_TMO])) break; if (_sp > XB_SPIN_CAP) { atomicAdd(&(bar)[XB_TMO], 1u); break; } } } } while (0)
struct XcdBarrier { unsigned* bar; unsigned x; volatile LAS unsigned* st; };
__device__ __forceinline__ void xcd_barrier_complete(unsigned* bar, unsigned x, unsigned G, unsigned& nloc, unsigned& nx) {
    unsigned sum, cnt, mine, sp = 0u;
    for (;;) {
        sum = 0u; cnt = 0u; mine = 0u;
#pragma unroll
        for (unsigned j = 0; j < 16; ++j) { const unsigned c = xb_ld(&bar[XB_XCNT(j)]); sum += c; cnt += (c > 0u) ? 1u : 0u; mine = (j == x) ? c : mine; }
        if (sum == G) break;
        __builtin_amdgcn_s_sleep(1);
        if ((++sp & 255u) == 0u) { if (xb_ld(&bar[XB_TMO])) break; if (sp > XB_SPIN_CAP) { atomicAdd(&bar[XB_TMO], 1u); break; } }
    }
    nloc = mine > 0u ? mine : 1u; nx = cnt > 0u ? cnt : 1u;
}
__device__ __forceinline__ void xcd_barrier(const XcdBarrier& b, const int tid, const unsigned G) {
    asm volatile("s_waitcnt vmcnt(0)" ::: "memory");
    __syncthreads();
    if (tid == 0) {
        unsigned* bar = b.bar;
        __builtin_amdgcn_s_waitcnt(0);
        unsigned nloc = b.st[0], nx = b.st[1];
        if (nloc == 0u) { xcd_barrier_complete(bar, b.x, G, nloc, nx); b.st[0] = nloc; b.st[1] = nx; }
        const unsigned old = xb_add(&bar[XB_XSUB(b.x)], 1u);
        const unsigned gen = old / nloc;
        if (old + 1u == (gen + 1u) * nloc) {
            __builtin_amdgcn_fence(__ATOMIC_RELEASE, "agent");
            asm volatile("s_waitcnt vmcnt(0)" ::: "memory");
            const unsigned og = xb_add(&bar[XB_TOP], 1u);
            const unsigned tg = og / nx;
            if (og + 1u == (tg + 1u) * nx) xb_add(&bar[XB_TOPGEN], 1u);
            else XB_SPIN(xb_ld(&bar[XB_TOPGEN]) == tg, bar);
            __builtin_amdgcn_fence(__ATOMIC_ACQUIRE, "agent");
            xb_add(&bar[XB_XGEN(b.x)], 1u);
            asm volatile("s_waitcnt vmcnt(0)" ::: "memory");
        } else {
            XB_SPIN(xb_ld(&bar[XB_XGEN(b.x)]) == gen, bar);
            __builtin_amdgcn_fence(__ATOMIC_ACQUIRE, "agent");
            asm volatile("s_waitcnt vmcnt(0)" ::: "memory");
        }
    }
    __syncthreads();
}
__device__ __forceinline__ void grp_barrier(unsigned* bar, const int g, const unsigned nmem, volatile LAS unsigned* st, const int tid) {
    asm volatile("s_waitcnt vmcnt(0)" ::: "memory");
    __syncthreads();
    if (tid == 0) {
        __builtin_amdgcn_s_waitcnt(0);
        unsigned mode = st[2];
        if (mode == 0u) {
            const unsigned np = xb_ld(&bar[GB_NPOST(g)]), m = xb_ld(&bar[GB_MASK(g)]);
            if (np == nmem) { mode = (__builtin_popcount(m) == 1) ? 1u : 2u; st[2] = mode; } else mode = 2u; }
        if (mode != 1u) { __builtin_amdgcn_fence(__ATOMIC_RELEASE, "agent"); asm volatile("s_waitcnt vmcnt(0)" ::: "memory"); }
        const unsigned old = xb_add(&bar[GB_CNT(g)], 1u);
        const unsigned gen = old / nmem;
        if (old + 1u == (gen + 1u) * nmem) xb_add(&bar[GB_GEN(g)], 1u);
        else XB_SPIN(xb_ld(&bar[GB_GEN(g)]) == gen, bar);
        __builtin_amdgcn_fence(__ATOMIC_ACQUIRE, "agent");
        asm volatile("s_waitcnt vmcnt(0)" ::: "memory");
    }
    __syncthreads();
}
constexpr size_t WS_BAR = 256 * 1024;
constexpr int LDS_CTL = LDS_BYTES - 64;
struct Args { const void* in[18]; float* out; unsigned char* ws; int ph_lo, ph_hi, li, pad; };

__device__ __forceinline__ unsigned pk2(float lo, float hi) { return (unsigned)f2bf(lo) | ((unsigned)f2bf(hi) << 16); }

struct P0Item { const float* W; const float* g; bf16_t* Wt; int ldw, N, k0, n0; };
__device__ __forceinline__ void p0_decode(int r, const Args& a, unsigned char* ws, P0Item& I) {
    constexpr int I1 = 32 * 128, I2 = 32 * 32, I3 = 32 * 129;
    int nblk;
    if (r < I1) { I.W = (const float*)a.in[3]; I.g = (const float*)a.in[2]; I.Wt = (bf16_t*)(ws + WS_W1T); I.ldw = NQKVG; I.N = NQKVG; nblk = 128; }
    else if (r < I1 + I2) { r -= I1; I.W = (const float*)a.in[11]; I.g = nullptr; I.Wt = (bf16_t*)(ws + WS_W2T); I.ldw = DM; I.N = DM; nblk = 32; }
    else if (r < I1 + I2 + I3) { r -= I1 + I2; I.W = (const float*)a.in[13]; I.g = (const float*)a.in[12]; I.Wt = (bf16_t*)(ws + WS_W3T); I.ldw = NQKVG + NFG; I.N = NQKVG + NFG; nblk = 129; }
    else { r -= I1 + I2 + I3; I.W = (const float*)a.in[17]; I.g = nullptr; I.Wt = (bf16_t*)(ws + WS_W4T); I.ldw = DM; I.N = DM; nblk = 32; }
    const int kb = r / nblk; I.k0 = kb * 64; I.n0 = (r - kb * nblk) * 64;
}
__device__ __forceinline__ void p0_load(const P0Item& I, int lane, f32x4 (&v)[16], float (&gv)[16]) {
    const int c4 = (lane & 15) * 4, kr = lane >> 4; const bool in = I.n0 + c4 < I.N;
    const float* p = I.W + (size_t)(I.k0 + kr) * I.ldw + I.n0 + c4;
#pragma unroll
    for (int i = 0; i < 16; ++i) { v[i] = in ? __builtin_nontemporal_load((const f32x4*)(p + (size_t)(4 * i) * I.ldw)) : (f32x4){0.f, 0.f, 0.f, 0.f}; gv[i] = I.g ? I.g[I.k0 + 4 * i + kr] : 1.0f; }
}
__device__ __forceinline__ void p0_emit(const P0Item& I, int lane, const f32x4 (&v)[16], const float (&gv)[16], LAS float* scr) {
    const int c4 = (lane & 15) * 4, kr = lane >> 4;
#pragma unroll
    for (int i = 0; i < 16; ++i) { LAS float* s = scr + (4 * i + kr) * 65 + c4; s[0] = v[i].x * gv[i]; s[1] = v[i].y * gv[i]; s[2] = v[i].z * gv[i]; s[3] = v[i].w * gv[i]; }
    asm volatile("s_waitcnt lgkmcnt(0)" ::: "memory");
    const int c = lane & 7;
#pragma unroll
    for (int j = 0; j < 8; ++j) { const int n = (lane >> 3) + 8 * j; const LAS float* s = scr + (8 * c) * 65 + n;
        uint4 o; o.x = pk2(s[0], s[65]); o.y = pk2(s[2 * 65], s[3 * 65]); o.z = pk2(s[4 * 65], s[5 * 65]); o.w = pk2(s[6 * 65], s[7 * 65]);
        if (I.n0 + n < I.N) *(uint4*)(I.Wt + (size_t)(I.n0 + n) * DM + I.k0 + 8 * c) = o; }
    asm volatile("s_waitcnt lgkmcnt(0)" ::: "memory");
}

__global__ void __launch_bounds__(NTHREADS, 2) mk_fwd(Args a) {
    extern __shared__ __attribute__((aligned(16))) unsigned char lds_raw[];
    LAS unsigned char* lds = (LAS unsigned char*)lds_raw;
    cg::grid_group grid = cg::this_grid();
    const int G = gridDim.x, bx = blockIdx.x;
    if (a.ph_lo < 0) grid.sync();
    const int wave_s = __builtin_amdgcn_readfirstlane((int)threadIdx.x >> 6);
    if (threadIdx.x < 16) ((LAS unsigned*)(lds + LDS_CTL))[threadIdx.x] = 0u;
    __syncthreads();
    XcdBarrier xbar; xbar.bar = (unsigned*)(a.ws + WS_BAR) + a.li * XCD_BAR_WORDS; xbar.x = xb_xcc_id(); xbar.st = (volatile LAS unsigned*)(lds + LDS_CTL);
    if (threadIdx.x == 0) { (void)xb_add(&xbar.bar[XB_XCNT(xbar.x)], 1u); (void)__hip_atomic_fetch_or(&xbar.bar[GB_MASK(bx & 7)], 1u << xbar.x, __ATOMIC_RELAXED, __HIP_MEMORY_SCOPE_AGENT);
                            __builtin_amdgcn_s_waitcnt(0); (void)xb_add(&xbar.bar[GB_NPOST(bx & 7)], 1u); }
#define GRID_BAR() do { PHASE_IDS(); xcd_barrier(xbar, tid, (unsigned)G); } while (0)
#define GROUP_BAR() do { PHASE_IDS(); if (G == 256) grp_barrier(xbar.bar, bx & 7, 32u, xbar.st, tid); else xcd_barrier(xbar, tid, (unsigned)G); } while (0)
#define PHASE_IDS() const int lane = lane_id_v(), wave = wave_s; const int tid = wave_s * 64 + lane; (void)wave
    unsigned char* ws = a.ws;
    const int lo = a.ph_lo, hi = a.ph_hi;
#if defined(ONLY_PHASE)
#define IN(k) ((k) == ONLY_PHASE && lo <= (k) && (k) < hi)
#elif defined(SKIP_PHASE)
#define IN(k) ((k) != SKIP_PHASE && lo <= (k) && (k) < hi)
#else
#define IN(k) (lo <= (k) && (k) < hi)
#endif
#define BOTH(k) (IN(k) && IN((k) + 1))
#ifdef REPEAT_PHASE
#define REP(k) for (int rep_ = 0; rep_ < ((k) == REPEAT_PHASE ? 2 : 1); ++rep_)
#else
#define REP(k)
#endif
    if (IN(0)) REP(0) {
        PHASE_IDS();
        const int gw = bx * NWAVES + wave, NGW = G * NWAVES;
        LAS float* scr = (LAS float*)(lds + wave * 16640);
        constexpr int NIT = 32 * 128 + 32 * 32 + 32 * 129 + 32 * 32;
        if (gw < NIT) {
            int it = gw; P0Item cur; f32x4 v[16]; float gv[16];
            p0_decode(it, a, ws, cur); p0_load(cur, lane, v, gv);
            for (;;) {
                const int itn = it + NGW; const bool more = itn < NIT;
                P0Item nxt = cur; f32x4 vn[16]; float gn[16];
                if (more) { p0_decode(itn, a, ws, nxt); p0_load(nxt, lane, vn, gn); }
                p0_emit(cur, lane, v, gv, scr);
                if (!more) break;
                cur = nxt; it = itn;
#pragma unroll
                for (int i = 0; i < 16; ++i) { v[i] = vn[i]; gv[i] = gn[i]; }
            }
        }
        { const float* x = (const float*)a.in[0]; bf16_t* xb = (bf16_t*)(ws + WS_XB); float* ssq0 = (float*)(ws + WS_SSQP);
          const bool xg = G == 256; const int rstep = xg ? 256 : NGW; const int rend = xg ? ((bx & 7) + 1) * SEQ : M;
          int row = xg ? (bx & 7) * SEQ + (bx >> 3) * NWAVES + wave : gw; f32x4 v[8];
          if (row < rend) {
            { const f32x4* xr = (const f32x4*)(x + (size_t)row * DM) + lane;
#pragma unroll
              for (int j = 0; j < 8; ++j) v[j] = __builtin_nontemporal_load(xr + 64 * j); }
            for (;;) {
                const int rown = row + rstep; const bool more = rown < rend; f32x4 vn[8];
                if (more) { const f32x4* xr = (const f32x4*)(x + (size_t)rown * DM) + lane;
#pragma unroll
                    for (int j = 0; j < 8; ++j) vn[j] = __builtin_nontemporal_load(xr + 64 * j); }
                float s = 0.f;
#pragma unroll
                for (int j = 0; j < 8; ++j) s += v[j].x * v[j].x + v[j].y * v[j].y + v[j].z * v[j].z + v[j].w * v[j].w;
#pragma unroll
                for (int o = 1; o < 64; o <<= 1) s += __shfl_xor(s, o);
                if (lane < 8) ssq0[(size_t)row * 8 + lane] = lane == 0 ? s : 0.f;
                uint2* o8 = (uint2*)(xb + (size_t)row * DM) + lane;
#pragma unroll
                for (int j = 0; j < 8; ++j) { uint2 w; w.x = pk2(v[j].x, v[j].y); w.y = pk2(v[j].z, v[j].w); o8[64 * j] = w; }
                if (!more) break;
                row = rown;
#pragma unroll
                for (int j = 0; j < 8; ++j) v[j] = vn[j];
            } } }
        { const int* pos = (const int*)a.in[1];
          const float inv_freq = (float)exp(-(double)((bx * NTHREADS + tid) & 15) / 16.0 * log(500000.0));
          for (int idx = bx * NTHREADS + tid; idx < M * 16; idx += G * NTHREADS) {
            const int row = idx >> 4;
            float c, s; sincos_acc((float)pos[row] * inv_freq, c, s);
            ((float*)(ws + WS_ROPE_COS))[idx] = c; ((float*)(ws + WS_ROPE_SIN))[idx] = s; }
          if (bx == 0 && wave == 0) {
            const float* lq1 = (const float*)a.in[6]; const float* lk1 = (const float*)a.in[7]; const float* lq2 = (const float*)a.in[8]; const float* lk2 = (const float*)a.in[9];
            float p = lq1[lane] * lk1[lane] + lq1[lane + 64] * lk1[lane + 64], q = lq2[lane] * lk2[lane] + lq2[lane + 64] * lk2[lane + 64];
#pragma unroll
            for (int o = 1; o < 64; o <<= 1) { p += __shfl_xor(p, o); q += __shfl_xor(q, o); }
            if (lane == 0) ((float*)(ws + WS_MISC))[0] = expf(p) - expf(q) + LAMBDA_INIT; } }
        if (BOTH(0)) GRID_BAR();
    }

    bool diff_stat_ok = false;
#define DIFF_BOUND() do { const int lane_ = lane_id_v(); const float* gq = (const float*)a.in[4]; const float* gk = (const float*)a.in[5];                  \
          float mq = fmaxf(fabsf(gq[lane_]), fabsf(gq[lane_ + 64])), mk = fmaxf(fabsf(gk[lane_]), fabsf(gk[lane_ + 64]));                                  \
          _Pragma("unroll") for (int o = 1; o < 64; o <<= 1) { mq = fmaxf(mq, __shfl_xor(mq, o)); mk = fmaxf(mk, __shfl_xor(mk, o)); }                     \
          const float b2 = 1.01f * 128.0f * mq * mk * att::SCALE * att::LOG2E;                                                                             \
          diff_stat_ok = __builtin_amdgcn_readfirstlane((int)(b2 <= 100.0f)) != 0; } while (0)
    if (IN(1)) REP(1) {
        PHASE_IDS();
#ifdef PROBE_GEMM_NOEPI
        { pg8::Gemm g{(const bf16_t*)(ws + WS_XB), (const bf16_t*)(ws + WS_W1T), M, NQKVG, DM}; pg8::StaticOrder S; S.init(M, NQKVG, G, bx, WGM_BIG); pg8::EpiNull E;
          pg8::gemm_phase<pg8::EpiNull, pg8::StaticOrder, true, PG8_SP2>(lds, g, S, E, tid); }
#endif
        pg8::Gemm g{(const bf16_t*)(ws + WS_XB), (const bf16_t*)(ws + WS_W1T), M, NQKVG, DM}; pg8::StaticOrder S; S.init(M, NQKVG, G, bx, WGM_BIG);
        pg8::EpiQKVG<true, true> E{(bf16_t*)(ws + WS_Q), (bf16_t*)(ws + WS_K), (bf16_t*)(ws + WS_V), (bf16_t*)(ws + WS_G), (const float*)(ws + WS_SSQP),
                                    (const float*)a.in[4], (const float*)a.in[5], (const float*)(ws + WS_ROPE_COS), (const float*)(ws + WS_ROPE_SIN), (LAS float*)(lds + EPI_OFF)};
        pg8::gemm_phase<pg8::EpiQKVG<true, true>, pg8::StaticOrder, true, PG8_SP2>(lds, g, S, E, tid);
        if (IN(2)) DIFF_BOUND();
        if (BOTH(1)) GROUP_BAR();
    }
    if (IN(2)) REP(2) {
        char* ldsg = (char*)lds_raw;
        const bf16_t* Qb = (const bf16_t*)(ws + WS_Q); const bf16_t* Kb = (const bf16_t*)(ws + WS_K); const bf16_t* Vb = (const bf16_t*)(ws + WS_V);
        const att::EpiDiff epi{(const bf16_t*)(ws + WS_G), (bf16_t*)(ws + WS_AO), (const float*)a.in[10], *(const float*)(ws + WS_MISC)};
        constexpr int NITEMS = 256;
        if (!IN(1)) DIFF_BOUND();
        const bool stat_ok = diff_stat_ok;
#define P2_RUN(ST_) do { \
        if (bx < NITEMS) { \
            att::Seam S; att::BlockRef cur = diff_ref(bx, 0, Qb, Kb, Vb); \
            att::attn_prime2<0>(cur, ldsg, S, wave_s); \
            for (int L = bx; L < NITEMS; L += G) \
                for (int qsel = 0; qsel < 2; ++qsel) { \
                    for (int p = 0; p < 2; ++p) { const int s = qsel * 4 + p; \
                        const att::BlockRef nxt = diff_ref(L, s + 1, Qb, Kb, Vb); \
                        att::attn_block2<0, att::EpiDiff, false, ST_>(cur, nxt, ldsg, S, epi, wave_s); cur = nxt; } \
                    for (int p = 2; p < 4; ++p) { const int s = qsel * 4 + p; const bool last_of_item = s == 7, more_item = L + G < NITEMS; \
                        const att::BlockRef nxt = !last_of_item ? diff_ref(L, s + 1, Qb, Kb, Vb) : (more_item ? diff_ref(L + G, 0, Qb, Kb, Vb) : cur); \
                        att::attn_block2<0, att::EpiDiff, true, ST_>(cur, nxt, ldsg, S, epi, wave_s); cur = nxt; } \
                } \
        } \
        } while (0)
        if (stat_ok) P2_RUN(true); else P2_RUN(false);
#undef P2_RUN
        if (BOTH(2)) GROUP_BAR();
    }
    if (IN(3)) REP(3) {
        PHASE_IDS();
        pg8::Gemm g{(const bf16_t*)(ws + WS_AO), (const bf16_t*)(ws + WS_W2T), M, DM, DM}; pg8::StaticOrder S; S.init(M, DM, G, bx, WGM_SMALL);
        pg8::EpiResMid E{(const float*)a.in[0], (bf16_t*)(ws + WS_XB), (float*)(ws + WS_SSQP), (LAS float*)(lds + EPI_OFF)};
        pg8::gemm_phase<pg8::EpiResMid, pg8::StaticOrder, true, PG8_SP2>(lds, g, S, E, tid);
        if (BOTH(3)) GROUP_BAR();
    }
    if (IN(4)) REP(4) {
        PHASE_IDS();
        {
            const bf16_t* xb = (const bf16_t*)(ws + WS_XB); const bf16_t* wf = (const bf16_t*)(ws + WS_W3T) + (size_t)NQKVG * DM;
            const float* ssqp = (const float*)(ws + WS_SSQP); float* logf_ = (float*)(ws + WS_LOGF); const float* fb = (const float*)a.in[14];
            LAS float* P = (LAS float*)(lds + EPI_OFF);
            for (int rr = bx; rr < M / 64; rr += G) { const int r0 = (G == 256) ? (rr & 7) * SEQ + (rr >> 3) * 64 : rr * 64;
                const int mt = wave & 3, kh = wave >> 2, ar = lane & 15, kq = lane >> 4;
                const bf16_t* ap = xb + (size_t)(r0 + 16 * mt + ar) * DM + kh * 1024 + 8 * kq; const bf16_t* bp = wf + (size_t)ar * DM + kh * 1024 + 8 * kq;
                f32x4 c = (f32x4){0.f, 0.f, 0.f, 0.f};
#pragma unroll 32
                for (int k = 0; k < 1024; k += 32) c = __builtin_amdgcn_mfma_f32_16x16x32_bf16(*(const bf16x8*)(ap + k), *(const bf16x8*)(bp + k), c, 0, 0, 0);
                if (kh == 1) { *(LAS f32x4*)(P + (mt * 64 + lane) * 4) = c; }
                __syncthreads();
                if (kh == 0) { const f32x4 o = *(const LAS f32x4*)(P + (mt * 64 + lane) * 4); const float b = fb[ar];
#pragma unroll
                    for (int j = 0; j < 4; ++j) { const int row = r0 + 16 * mt + 4 * kq + j;
                        const f32x4 pa = *(const f32x4*)(ssqp + (size_t)row * 8), pb = *(const f32x4*)(ssqp + (size_t)row * 8 + 4);
                        const float rs = 1.0f / sqrtf(((pa[0] + pa[1]) + (pa[2] + pa[3]) + (pb[0] + pb[1]) + (pb[2] + pb[3])) * (1.0f / 2048.f) + EPS);
                        const float z = (c[j] + o[j]) * rs + b;
                        logf_[((size_t)(row >> 11) * 16 + ar) * SEQ + (row & (SEQ - 1))] = fminf(z, 0.f) - log1pf(expf(-fabsf(z))); } }
                __syncthreads();
            }
        }
        pg8::Gemm g{(const bf16_t*)(ws + WS_XB), (const bf16_t*)(ws + WS_W3T), M, NQKVG, DM}; pg8::StaticOrder S; S.init(M, NQKVG, G, bx, WGM_BIG);
        pg8::EpiQKVG<false, true> E{(bf16_t*)(ws + WS_Q), (bf16_t*)(ws + WS_K), (bf16_t*)(ws + WS_V), (bf16_t*)(ws + WS_G), (const float*)(ws + WS_SSQP),
                                    (const float*)a.in[15], (const float*)a.in[16], nullptr, nullptr, (LAS float*)(lds + EPI_OFF)};
        pg8::gemm_phase<pg8::EpiQKVG<false, true>, pg8::StaticOrder, true, PG8_SP2>(lds, g, S, E, tid);
        if (IN(5)) fox_setup((const float*)a.in[14], (const float*)a.in[15], (const float*)a.in[16], (char*)lds_raw, wave_s);
        if (BOTH(4)) GROUP_BAR();
    }
    if (IN(5)) REP(5) {
        char* ldsg = (char*)lds_raw;
        const bf16_t* Qb = (const bf16_t*)(ws + WS_Q); const bf16_t* Kb = (const bf16_t*)(ws + WS_K); const bf16_t* Vb = (const bf16_t*)(ws + WS_V);
        const att::EpiFox epi{(const bf16_t*)(ws + WS_G), (bf16_t*)(ws + WS_AO)};
        constexpr int NITEMS = 512;
        const int* ord = (const int*)(ldsg + att::OFF_SSQ + 1024 + 64);
        if (!IN(4)) fox_setup((const float*)a.in[14], (const float*)a.in[15], (const float*)a.in[16], ldsg, wave_s);
        const bool stat_ok = __builtin_amdgcn_readfirstlane((int)(*(const float*)(ldsg + att::OFF_SSQ + 1024 + 132) <= 100.0f)) != 0;
#define P5_RUN(ST_) do { \
        int L = bx, pass = 0; \
        if (L < NITEMS) { \
            att::Seam S; att::BlockRef cur = fox_ref(L, 0, ord, Qb, Kb, Vb); \
            att::attn_prime2<1>(cur, ldsg, S, wave_s); \
            for (;;) { \
                const bool more_pass = pass == 0, more_item = L + G < NITEMS, last = !more_pass && !more_item; \
                const int Ln = more_pass ? L : (more_item ? L + G : L), passn = more_pass ? 1 : 0; \
                const att::BlockRef nxt = last ? cur : fox_ref(Ln, passn, ord, Qb, Kb, Vb); \
                if (pass == 0) fox_bias((const float*)(ws + WS_LOGF) + (size_t)((L & 7) * 16 + cur.head) * SEQ, ldsg, wave_s); \
                cur.jlo = __builtin_amdgcn_readfirstlane(fox_jlo(cur.P0, ldsg)); \
                att::attn_block2<1, att::EpiFox, false, ST_>(cur, nxt, ldsg, S, epi, wave_s); \
                if (last) break; \
                cur = nxt; L = Ln; pass = passn; \
            } \
        } \
        } while (0)
        if (stat_ok) P5_RUN(true); else P5_RUN(false);
#undef P5_RUN
        if (BOTH(5)) GROUP_BAR();
    }
    if (IN(6)) {
        PHASE_IDS();
        pg8::Gemm g{(const bf16_t*)(ws + WS_AO), (const bf16_t*)(ws + WS_W4T), M, DM, DM}; pg8::StaticOrder S; S.init(M, DM, G, bx, WGM_SMALL);
        pg8::EpiResOut E{(const bf16_t*)(ws + WS_XB), a.out};
        pg8::gemm_phase<pg8::EpiResOut, pg8::StaticOrder, true, PG8_SP2>(lds, g, S, E, tid);
    }
#undef IN
#undef BOTH
}

static int mk_grid() {
    static int grid = 0;
    if (grid == 0) {
        int dev = 0, cus = 0, per_cu = 0;
        if (hipGetDevice(&dev) != hipSuccess || hipDeviceGetAttribute(&cus, hipDeviceAttributeMultiprocessorCount, dev) != hipSuccess) { fprintf(stderr, "mk: device query failed\n"); grid = -1; return grid; }
        if (hipFuncSetAttribute((const void*)mk_fwd, hipFuncAttributeMaxDynamicSharedMemorySize, LDS_BYTES) != hipSuccess) { fprintf(stderr, "mk: hipFuncSetAttribute failed\n"); grid = -1; return grid; }
        if (hipOccupancyMaxActiveBlocksPerMultiprocessor(&per_cu, (const void*)mk_fwd, NTHREADS, LDS_BYTES) != hipSuccess || per_cu < 1) { fprintf(stderr, "mk: occupancy query says %d\n", per_cu); grid = -1; return grid; }
        (void)hipGetLastError();
        grid = cus;
        fprintf(stderr, "mk: cus %d per_cu %d grid %d\n", cus, per_cu, grid);
    }
    return grid;
}
static void mk_launch(void* const* d_in, void* d_out, void* d_ws, int ph_lo, int ph_hi, int li, hipStream_t stream) {
    const int grid = mk_grid(); if (grid <= 0) return;
    Args a{}; for (int i = 0; i < 18; ++i) a.in[i] = d_in[i];
    a.out = (float*)d_out; a.ws = (unsigned char*)d_ws; a.ph_lo = ph_lo; a.ph_hi = ph_hi; a.li = li;
    void* args[] = {&a};
    hipError_t e = hipLaunchCooperativeKernel((const void*)mk_fwd, dim3(grid), dim3(NTHREADS), args, LDS_BYTES, stream);
    if (e != hipSuccess) fprintf(stderr, "mk: cooperative launch failed: %s\n", hipGetErrorString(e));
}

extern "C" void kernel_launch(void* const* d_in, const int* in_sizes, int n_in, void* d_out, int out_size, void* d_ws, size_t ws_size, hipStream_t stream) {
    if (n_in != 18 || in_sizes[0] != M * DM || out_size != M * DM || ws_size < WS_END) { fprintf(stderr, "kernel_launch: unexpected shapes (n_in %d, in0 %d, out %d, ws %zu)\n", n_in, n_in > 0 ? in_sizes[0] : -1, out_size, ws_size); return; }
    (void)hipMemsetAsync((char*)d_ws + WS_BAR, 0, 4 * XCD_BAR_WORDS * 4, stream);
#ifdef PROBE_PHASE
    mk_launch(d_in, d_out, d_ws, 0, PROBE_PHASE + 1, 0, stream); mk_launch(d_in, d_out, d_ws, PROBE_PHASE, 7, 1, stream);
#else
    mk_launch(d_in, d_out, d_ws, 0, 7, 0, stream);
#endif
}
```
